# Optimizing an MI355X kernel written in HIP

```python
import jax, jax.numpy as jnp
from jax import lax
import numpy as np

D_MODEL = 1024
BATCH = 16
SEQ = 2048
DEPTH = 1

D_MIX = D_MODEL
ATTN_HEADS = 8
HEAD_DIM = 64
D_ATTN = ATTN_HEADS * HEAD_DIM
D_CONV = D_MIX - D_ATTN
CONV_GROUPS = 8
CONV_K = 31
DILATED_PATTERNS = ((128, 1), (512, 4), (2048, 16))
BLK = 128
D_FF = 2816
D_IN = 3 * D_ATTN + 2 * D_CONV
EPS = 1e-6

kernel_name = "hybrid_dilated_attn_conformer_conv_macaron"


def _rms(x, g):
    xf = x.astype(jnp.float32)
    y = xf * lax.rsqrt(jnp.mean(xf * xf, axis=-1, keepdims=True) + EPS)
    return (y * g.astype(jnp.float32)).astype(x.dtype)


def _layernorm(x, g, b):
    xf = x.astype(jnp.float32)
    mu = jnp.mean(xf, axis=-1, keepdims=True)
    var = jnp.mean(jnp.square(xf - mu), axis=-1, keepdims=True)
    y = (xf - mu) * lax.rsqrt(var + EPS)
    return (y * g.astype(jnp.float32) + b.astype(jnp.float32)).astype(x.dtype)


def _swiglu(x, w_gate, w_up, w_down):
    return (jax.nn.silu(x @ w_gate) * (x @ w_up)) @ w_down


def _banded_causal_attn(q, k, v, steps):
    Bp, L, H, Dh = q.shape
    N = L // BLK
    qb = q.reshape(Bp, N, BLK, H, Dh)
    kb = k.reshape(Bp, N, BLK, H, Dh)
    vb = v.reshape(Bp, N, BLK, H, Dh)

    def with_prev(a):
        prev = jnp.concatenate([jnp.zeros_like(a[:, :1]), a[:, :-1]], axis=1)
        return jnp.concatenate([prev, a], axis=2)

    kk, vv = with_prev(kb), with_prev(vb)
    s = jnp.einsum('bnqhd,bnkhd->bnhqk', qb, kk,
                   preferred_element_type=jnp.float32) * (Dh ** -0.5)
    qi = jnp.arange(BLK)[:, None]
    ci = jnp.arange(2 * BLK)[None, :]
    dist = BLK + qi - ci
    band = (dist >= 0) & (dist <= steps)
    first = (jnp.arange(N) == 0)[:, None, None] & (ci < BLK)[None]
    mask = band[None] & jnp.logical_not(first)
    s = jnp.where(mask[None, :, None], s, jnp.float32(-1e30))
    m = jnp.max(s, axis=-1, keepdims=True)
    p = jnp.exp(s - m)
    l = jnp.sum(p, axis=-1, keepdims=True)
    o = jnp.einsum('bnhqk,bnkhd->bnqhd', (p / l).astype(v.dtype), vv,
                   preferred_element_type=jnp.float32)
    lse = (m + jnp.log(l))[..., 0]
    return o.reshape(Bp, L, H, Dh), lse.transpose(0, 1, 3, 2).reshape(Bp, L, H)


def _dilated_causal_attn(q, k, v, window, dilation):
    B, S, H, Dh = q.shape
    span = dilation * BLK
    S_pad = -(-S // span) * span
    L = S_pad // dilation

    def strided(a):
        a = jnp.pad(a, ((0, 0), (0, S_pad - S), (0, 0), (0, 0)))
        return a.reshape(B, L, dilation, H, Dh).transpose(0, 2, 1, 3, 4).reshape(B * dilation, L, H, Dh)

    o, lse = _banded_causal_attn(strided(q), strided(k), strided(v), window // dilation)
    o = o.reshape(B, dilation, L, H, Dh).transpose(0, 2, 1, 3, 4).reshape(B, S_pad, H, Dh)[:, :S]
    lse = lse.reshape(B, dilation, L, H).transpose(0, 2, 1, 3).reshape(B, S_pad, H)[:, :S]
    return o, lse


def _conformer_conv(a, gate, conv_w, conv_b, ln_g, ln_b):
    glu = a * jax.nn.sigmoid(gate)
    y = lax.conv_general_dilated(
        glu, conv_w[:, None, :], window_strides=(1,), padding=[(CONV_K - 1, 0)],
        dimension_numbers=('NWC', 'WIO', 'NWC'), feature_group_count=D_CONV)
    y = y + conv_b
    return jax.nn.silu(_layernorm(y, ln_g, ln_b))


def setup_inputs(seed: int = 0) -> dict:
    key = jax.random.key(seed)
    ks = jax.random.split(key, 20)
    L = DEPTH

    def nrm(k, shape, scale):
        return jax.random.normal(k, shape, jnp.float32) * scale

    def gain(k, shape):
        return 1.0 + 0.02 * jax.random.normal(k, shape, jnp.float32)

    return {
        "x": jax.random.normal(ks[0], (BATCH, SEQ, D_MODEL), jnp.float32),
        "ffn1_norm": gain(ks[1], (L, D_MODEL)),
        "ffn1_w_gate": nrm(ks[2], (L, D_MODEL, D_FF), D_MODEL ** -0.5),
        "ffn1_w_up": nrm(ks[3], (L, D_MODEL, D_FF), D_MODEL ** -0.5),
        "ffn1_w_down": nrm(ks[4], (L, D_FF, D_MODEL), D_FF ** -0.5),
        "mix_norm": gain(ks[5], (L, D_MODEL)),
        "w_in": nrm(ks[6], (L, D_MODEL, D_IN), D_MODEL ** -0.5),
        "q_norm": gain(ks[7], (L, HEAD_DIM)),
        "k_norm": gain(ks[8], (L, HEAD_DIM)),
        "conv_w": nrm(ks[9], (L, CONV_K, D_CONV), CONV_K ** -0.5),
        "conv_b": nrm(ks[10], (L, D_CONV), 0.02),
        "conv_ln_g": gain(ks[11], (L, D_CONV)),
        "conv_ln_b": nrm(ks[12], (L, D_CONV), 0.02),
        "w_out": nrm(ks[13], (L, D_MIX, D_MODEL), D_MIX ** -0.5),
        "ffn2_norm": gain(ks[14], (L, D_MODEL)),
        "ffn2_w_gate": nrm(ks[15], (L, D_MODEL, D_FF), D_MODEL ** -0.5),
        "ffn2_w_up": nrm(ks[16], (L, D_MODEL, D_FF), D_MODEL ** -0.5),
        "ffn2_w_down": nrm(ks[17], (L, D_FF, D_MODEL), D_FF ** -0.5),
    }


def reference(x, ffn1_norm, ffn1_w_gate, ffn1_w_up, ffn1_w_down, mix_norm, w_in, q_norm, k_norm,
              conv_w, conv_b, conv_ln_g, conv_ln_b, w_out, ffn2_norm, ffn2_w_gate, ffn2_w_up,
              ffn2_w_down):
    B, S, _ = x.shape
    h = x
    for l in range(DEPTH):
        h = h + 0.5 * _swiglu(_rms(h, ffn1_norm[l]), ffn1_w_gate[l], ffn1_w_up[l], ffn1_w_down[l])

        u = _rms(h, mix_norm[l]) @ w_in[l]
        q, k, v, ca, cg = jnp.split(
            u, np.cumsum([D_ATTN, D_ATTN, D_ATTN, D_CONV]).tolist(), axis=-1)

        q = _rms(q.reshape(B, S, ATTN_HEADS, HEAD_DIM), q_norm[l])
        k = _rms(k.reshape(B, S, ATTN_HEADS, HEAD_DIM), k_norm[l])
        v = v.reshape(B, S, ATTN_HEADS, HEAD_DIM)
        outs, lses = [], []
        for window, dilation in DILATED_PATTERNS:
            o, lse = _dilated_causal_attn(q, k, v, window, dilation)
            outs.append(o)
            lses.append(lse)
        wts = jax.nn.softmax(jnp.stack(lses, axis=0), axis=0)
        attn = jnp.sum(wts[..., None] * jnp.stack(outs, axis=0), axis=0)
        attn = attn.reshape(B, S, D_ATTN).astype(h.dtype)

        conv = _conformer_conv(ca, cg, conv_w[l], conv_b[l], conv_ln_g[l], conv_ln_b[l])

        h = h + jnp.concatenate([attn, conv], axis=-1) @ w_out[l]

        h = h + 0.5 * _swiglu(_rms(h, ffn2_norm[l]), ffn2_w_gate[l], ffn2_w_up[l], ffn2_w_down[l])
    return h
```

```cpp
#include <hip/hip_runtime.h>
#include <hip/hip_cooperative_groups.h>
#include <cstdio>
#include <cstdint>
namespace cg = cooperative_groups;
constexpr size_t MiB = 1u << 20;
constexpr size_t WS_WGU1 = 1 * MiB;
constexpr size_t WS_WD1 = 13 * MiB;
constexpr size_t WS_WIN = 19 * MiB;
constexpr size_t WS_WOUT = 24 * MiB;
constexpr size_t WS_WGU2 = 26 * MiB;
constexpr size_t WS_WD2 = 38 * MiB;
constexpr size_t WS_SL1 = 44 * MiB;
constexpr size_t WS_SL2 = 46 * MiB;
constexpr size_t WS_AB = 48 * MiB;
constexpr size_t WS_HMID = 112 * MiB;
constexpr size_t WS_Q = WS_HMID, WS_K = WS_HMID + 32 * MiB, WS_V = WS_HMID + 64 * MiB, WS_G = WS_HMID + 96 * MiB, WS_MIX = WS_HMID + 128 * MiB;
constexpr size_t WS_END = WS_HMID + 192 * MiB;
namespace pg8 {
#define PG8_LAS __attribute__((address_space(3)))
typedef unsigned short bf16_t;
typedef short bf16x8 __attribute__((ext_vector_type(8)));
typedef float f32x4 __attribute__((ext_vector_type(4)));
typedef unsigned u32x4 __attribute__((ext_vector_type(4)));
constexpr int BM = 256, BK = 64, HALF = 128, HTB = HALF * BK * 2  , STAGE_BYTES = 8 * HTB, NXCD = 8, WGM = 4;

__host__ __device__ __forceinline__ int lds_byte(int r, int c) { const int st = (r >> 4) * 2 + (c >> 5), rr = r & 15, cc = c & 31, ob = rr * 64 + cc * 2; return st * 1024 + (ob ^ (((ob >> 9) & 1) << 5)); }
__host__ __device__ __forceinline__ void stage_rc(int b, int& R, int& C) { const int st = b / 1024, sb = b % 1024, swz = sb ^ (((sb >> 9) & 1) << 5); R = (st >> 1) * 16 + swz / 64; C = (st & 1) * 32 + (swz % 64) / 2; }
__host__ __device__ __forceinline__ int perm32(int rho) { const int n = rho >> 4, i = rho & 15; return 8 * (i >> 2) + 4 * n + (i & 3); }

struct Unit { int pm, pn; };
struct Gemm { const bf16_t* A; const bf16_t* Bt; int M, N, K; };

struct StaticOrder {
    int nM, nN, nwg, G, c, rev;
    __host__ __device__ void init(int M, int N, int G_, int c_) { nM = M / BM; nN = N / BM; nwg = nM * nN; G = G_; c = c_; rev = 0; }
    __host__ __device__ bool next(int i, Unit& u) const {
        const long L = (long)i * G + c; if (L >= nwg) return false;
        int wgid = (int)L; { const int q = nwg / NXCD, r = nwg % NXCD, xcd = wgid % NXCD, off = wgid / NXCD; wgid = (xcd < r ? xcd * (q + 1) : r * (q + 1) + (xcd - r) * q) + off; }
        const int nig = WGM * nN, gid = wgid / nig, fm = gid * WGM, gsz = (nM - fm) < WGM ? (nM - fm) : WGM;
        u.pm = fm + ((wgid % nig) % gsz); u.pn = (wgid % nig) / gsz; if (rev) u.pm = nM - 1 - u.pm; return true;
    }
    __device__ __forceinline__ void a_ready(const Unit&) const {}
    __device__ __forceinline__ void done(const Unit&) const {}
};

__device__ __forceinline__ unsigned cvt_pk_bf16(float lo, float hi) { unsigned r; asm volatile("v_cvt_pk_bf16_f32 %0, %1, %2" : "=v"(r) : "v"(lo), "v"(hi)); return r; }
typedef float f32x2 __attribute__((ext_vector_type(2)));
constexpr float LOG2E = 1.4426950408889634f;
__device__ __forceinline__ float sigm(float g) { return __builtin_amdgcn_rcpf(1.0f + __builtin_amdgcn_exp2f(-g * LOG2E)); }
__device__ __forceinline__ void rows_rstd(float (&rs)[2][4], const float* slots, int row0, int fq) {
    f32x4 sl[2][4];
#pragma unroll
    for (int ai = 0; ai < 2; ++ai)
#pragma unroll
        for (int m = 0; m < 4; ++m) sl[ai][m] = *(const f32x4*)(slots + (size_t)(row0 + ai * HALF + m * 16) * 16 + 4 * fq);
#pragma unroll
    for (int ai = 0; ai < 2; ++ai)
#pragma unroll
        for (int m = 0; m < 4; ++m) { float t = (sl[ai][m][0] + sl[ai][m][1]) + (sl[ai][m][2] + sl[ai][m][3]); t += __shfl_xor(t, 16); t += __shfl_xor(t, 32);
            rs[ai][m] = __builtin_amdgcn_rsqf(t * (1.0f / 1024.0f) + 1e-6f); }
}
template <bool SCALE> struct EpiSwiglu {
    static constexpr bool PERM = true, AFTER_DRAIN = false;
    bf16_t* O; const float* slots;
    __device__ __forceinline__ void operator()(const f32x4 (&acc)[2][2][4][2], const Unit& u, int wr, int wc, int fr, int fq) const {
        const int row0 = u.pm * BM + wr * 64 + fr, col0 = u.pn * 128 + wc * 32 + 8 * fq;
        float rsa[2][4]; if (SCALE) rows_rstd(rsa, slots, row0, fq);
#pragma unroll
        for (int ai = 0; ai < 2; ++ai)
#pragma unroll
            for (int m = 0; m < 4; ++m) {
                const int row = row0 + ai * HALF + m * 16; float rs = 1.f; if (SCALE) rs = rsa[ai][m];
                u32x4 w;
#pragma unroll
                for (int n = 0; n < 2; ++n) { const f32x4 g = acc[ai][0][m][n] * rs, uu = acc[ai][1][m][n] * rs; f32x4 o;
#pragma unroll
                    for (int e = 0; e < 4; ++e) o[e] = g[e] * uu[e] * __builtin_amdgcn_rcpf(1.0f + __builtin_amdgcn_exp2f(g[e]));
                    w[2 * n] = cvt_pk_bf16(o[0], o[1]); w[2 * n + 1] = cvt_pk_bf16(o[2], o[3]); }
                *(u32x4*)(O + (size_t)row * 2816 + col0) = w; }
    }
};
template <int MODE> struct EpiRes {
    static constexpr bool PERM = true, AFTER_DRAIN = false;
    const float* x; bf16_t* hb; float* out; float* slots; float alpha;
    static __device__ __forceinline__ f32x4 lo4(u32x4 w) { return (f32x4){__builtin_bit_cast(float, w.x << 16), __builtin_bit_cast(float, w.x & 0xffff0000u), __builtin_bit_cast(float, w.y << 16), __builtin_bit_cast(float, w.y & 0xffff0000u)}; }
    static __device__ __forceinline__ f32x4 hi4(u32x4 w) { return (f32x4){__builtin_bit_cast(float, w.z << 16), __builtin_bit_cast(float, w.z & 0xffff0000u), __builtin_bit_cast(float, w.w << 16), __builtin_bit_cast(float, w.w & 0xffff0000u)}; }
    __device__ __forceinline__ void finish(f32x4 o0, f32x4 o1, size_t off, float& ss) const {
        if (MODE == 2) { *(f32x4*)(out + off) = o0; *(f32x4*)(out + off + 4) = o1; }
        else { u32x4 w; w.x = cvt_pk_bf16(o0[0], o0[1]); w.y = cvt_pk_bf16(o0[2], o0[3]); w.z = cvt_pk_bf16(o1[0], o1[1]); w.w = cvt_pk_bf16(o1[2], o1[3]);
            *(u32x4*)(hb + off) = w;
            ss += (o0[0] * o0[0] + o0[1] * o0[1]) + (o0[2] * o0[2] + o0[3] * o0[3]) + (o1[0] * o1[0] + o1[1] * o1[1]) + (o1[2] * o1[2] + o1[3] * o1[3]); }
    }
    __device__ __forceinline__ void operator()(const f32x4 (&acc)[2][2][4][2], const Unit& u, int wr, int wc, int fr, int fq) const {
        const int row0 = u.pm * BM + wr * 64 + fr, col0 = u.pn * BM + wc * 32 + 8 * fq;
        if (MODE == 0) {
#pragma unroll
            for (int ai = 0; ai < 2; ++ai) {
                f32x4 b[4][2][2];
#pragma unroll
                for (int m = 0; m < 4; ++m)
#pragma unroll
                    for (int bj = 0; bj < 2; ++bj) { const size_t off = (size_t)(row0 + ai * HALF + m * 16) * 1024 + col0 + bj * HALF; b[m][bj][0] = *(const f32x4*)(x + off); b[m][bj][1] = *(const f32x4*)(x + off + 4); }
#pragma unroll
                for (int m = 0; m < 4; ++m) { const int row = row0 + ai * HALF + m * 16; float ss = 0.f;
#pragma unroll
                    for (int bj = 0; bj < 2; ++bj) finish(b[m][bj][0] + acc[ai][bj][m][0] * alpha, b[m][bj][1] + acc[ai][bj][m][1] * alpha, (size_t)row * 1024 + col0 + bj * HALF, ss);
                    ss += __shfl_xor(ss, 16); ss += __shfl_xor(ss, 32); if (fq == 0) slots[(size_t)row * 16 + u.pn * 4 + wc] = ss; } }
        } else {
            u32x4 b[2][4][2];
#pragma unroll
            for (int ai = 0; ai < 2; ++ai)
#pragma unroll
                for (int m = 0; m < 4; ++m)
#pragma unroll
                    for (int bj = 0; bj < 2; ++bj) b[ai][m][bj] = *(const u32x4*)(hb + (size_t)(row0 + ai * HALF + m * 16) * 1024 + col0 + bj * HALF);
#pragma unroll
            for (int ai = 0; ai < 2; ++ai)
#pragma unroll
                for (int m = 0; m < 4; ++m) { const int row = row0 + ai * HALF + m * 16; float ss = 0.f;
#pragma unroll
                    for (int bj = 0; bj < 2; ++bj) finish(lo4(b[ai][m][bj]) + acc[ai][bj][m][0] * alpha, hi4(b[ai][m][bj]) + acc[ai][bj][m][1] * alpha, (size_t)row * 1024 + col0 + bj * HALF, ss);
                    if (MODE == 1) { ss += __shfl_xor(ss, 16); ss += __shfl_xor(ss, 32); if (fq == 0) slots[(size_t)row * 16 + u.pn * 4 + wc] = ss; } }
        }
    }
};
struct EpiWin {
    static constexpr bool PERM = true, AFTER_DRAIN = false;
    unsigned char* ws; const float* slots; const float *qg, *kg;
    static __device__ __forceinline__ unsigned kvoff(int sh, int bh, int t) { return (unsigned)((bh * 2048 + (t & ((1 << sh) - 1)) * (2048 >> sh) + (t >> sh)) * 64); }
    __device__ __forceinline__ void operator()(const f32x4 (&acc)[2][2][4][2], const Unit& u, int wr, int wc, int fr, int fq) const {
        const int row0 = u.pm * BM + wr * 64 + fr, pn = u.pn;
        float rsa[2][4]; rows_rstd(rsa, slots, row0, fq);
        if (pn < 4) {
            const bool isq = pn < 2; const float* gn = isq ? qg : kg; const float sc = isq ? 0.125f * LOG2E : 1.0f;
            const int head = (pn & 1) * 4 + wc, hcol = head * 64 + 8 * fq;
            f32x4 gv[2][2];
#pragma unroll
            for (int bj = 0; bj < 2; ++bj)
#pragma unroll
                for (int n = 0; n < 2; ++n) gv[bj][n] = *(const f32x4*)(gn + bj * 32 + 8 * fq + 4 * n) * sc;
#pragma unroll
            for (int ai = 0; ai < 2; ++ai)
#pragma unroll
                for (int m = 0; m < 4; ++m) {
                    const int row = row0 + ai * HALF + m * 16; const float rs = rsa[ai][m];
                    f32x4 v[2][2]; float ss = 0.f;
#pragma unroll
                    for (int bj = 0; bj < 2; ++bj)
#pragma unroll
                        for (int n = 0; n < 2; ++n) { v[bj][n] = acc[ai][bj][m][n] * rs; const f32x4 q = v[bj][n] * v[bj][n]; ss += (q[0] + q[1]) + (q[2] + q[3]); }
                    ss += __shfl_xor(ss, 16); ss += __shfl_xor(ss, 32);
                    const float rinv = __builtin_amdgcn_rsqf(ss * (1.0f / 64.0f) + 1e-6f);
#pragma unroll
                    for (int bj = 0; bj < 2; ++bj) { const f32x4 o0 = v[bj][0] * rinv * gv[bj][0], o1 = v[bj][1] * rinv * gv[bj][1];
                        u32x4 w; w.x = cvt_pk_bf16(o0[0], o0[1]); w.y = cvt_pk_bf16(o0[2], o0[3]); w.z = cvt_pk_bf16(o1[0], o1[1]); w.w = cvt_pk_bf16(o1[2], o1[3]);
                        if (isq) *(u32x4*)((bf16_t*)(ws + WS_Q) + (size_t)row * 512 + hcol + bj * 32) = w;
                        else { const int bh = (row >> 11) * 8 + head, t = row & 2047, dd = bj * 32 + 8 * fq; bf16_t* K1 = (bf16_t*)(ws + WS_K) + dd;
                            *(u32x4*)(K1 + kvoff(0, bh, t)) = w; } } }
        } else if (pn < 6) {
            const int col0 = (pn - 4) * BM + wc * 32 + 8 * fq;
#pragma unroll
            for (int ai = 0; ai < 2; ++ai)
#pragma unroll
                for (int m = 0; m < 4; ++m) {
                    const int row = row0 + ai * HALF + m * 16; const float rs = rsa[ai][m];
#pragma unroll
                    for (int bj = 0; bj < 2; ++bj) { const f32x4 o0 = acc[ai][bj][m][0] * rs, o1 = acc[ai][bj][m][1] * rs;
                        u32x4 w; w.x = cvt_pk_bf16(o0[0], o0[1]); w.y = cvt_pk_bf16(o0[2], o0[3]); w.z = cvt_pk_bf16(o1[0], o1[1]); w.w = cvt_pk_bf16(o1[2], o1[3]);
                        const int col = col0 + bj * HALF, bh = (row >> 11) * 8 + (col >> 6), t = row & 2047, dd = col & 63;
                        bf16_t* V1 = (bf16_t*)(ws + WS_V) + dd;
                        *(u32x4*)(V1 + kvoff(0, bh, t)) = w; } }
        } else {
            const int col0 = (pn - 6) * 128 + wc * 32 + 8 * fq;
#pragma unroll
            for (int ai = 0; ai < 2; ++ai)
#pragma unroll
                for (int m = 0; m < 4; ++m) {
                    const int row = row0 + ai * HALF + m * 16; const float rs = rsa[ai][m];
                    u32x4 w;
#pragma unroll
                    for (int n = 0; n < 2; ++n) { const f32x4 a = acc[ai][0][m][n] * rs, g = acc[ai][1][m][n] * rs; f32x4 o;
#pragma unroll
                        for (int e = 0; e < 4; ++e) o[e] = a[e] * sigm(g[e]);
                        w[2 * n] = cvt_pk_bf16(o[0], o[1]); w[2 * n + 1] = cvt_pk_bf16(o[2], o[3]); }
                    *(u32x4*)((bf16_t*)(ws + WS_G) + (size_t)row * 512 + col0) = w; }
        }
    }
};

template <class Epi, class Sched, bool ALIGN_EPI = false, bool SP2 = false>
__device__ __forceinline__ void gemm_phase(PG8_LAS unsigned char* lds, const Gemm g, const Sched& S, const Epi& E) {
    int tid_ = threadIdx.x; asm volatile("" : "+v"(tid_));
    const int tid = tid_, wid = __builtin_amdgcn_readfirstlane(tid >> 6), lane = tid & 63, wr = wid >> 2, wc = wid & 3, fr = lane & 15, fq = lane >> 4;
    const int K = g.K, nt = K / BK;
    unsigned voffA[2], voffB[2];
#pragma unroll
    for (int i = 0; i < 2; ++i) { int R, C; stage_rc(tid * 16 + i * 8192, R, C); const int Rb = Epi::PERM ? ((R & ~31) + perm32(R & 31)) : R;
        voffA[i] = (unsigned)(R * K + C) * 2u; voffB[i] = (unsigned)(Rb * K + C) * 2u; }
    const size_t kstep = (size_t)(BK * 2);
    const size_t hstep = (size_t)HALF * K * 2;
    const size_t tstep = 2 * hstep;
    const unsigned ldsw = (unsigned)wid * 1024u;
    const int aoff = lds_byte(wr * 64 + fr, fq * 8), boff = lds_byte(wc * 32 + fr, fq * 8);
#define PG8_SA(b, h) (((b) * 2 + (h)) * HTB)
#define PG8_SB(b, h) ((4 + (b) * 2 + (h)) * HTB)
#define PG8_STAGE(bufoff, gbase, voff) do { _Pragma("unroll") for (int _i = 0; _i < 2; ++_i) \
        __builtin_amdgcn_global_load_lds((const unsigned*)((const char*)(gbase) + (voff)[_i]), (PG8_LAS unsigned*)(lds + (bufoff) + ldsw + _i * 8192), 16, 0, 0); } while (0)
#define PG8_LDA(dst, b, h) do { _Pragma("unroll") for (int m = 0; m < 4; ++m) _Pragma("unroll") for (int k = 0; k < 2; ++k) dst[m][k] = *(const PG8_LAS bf16x8*)(lds + PG8_SA(b, h) + aoff + m * 2048 + k * 1024); } while (0)
#define PG8_LDB(dst, b, h) do { _Pragma("unroll") for (int n = 0; n < 2; ++n) _Pragma("unroll") for (int k = 0; k < 2; ++k) dst[n][k] = *(const PG8_LAS bf16x8*)(lds + PG8_SB(b, h) + boff + n * 2048 + k * 1024); } while (0)
#define PG8_MMA(ai, bj, At, Bt) do { __builtin_amdgcn_s_setprio(1); _Pragma("unroll") for (int m = 0; m < 4; ++m) _Pragma("unroll") for (int n = 0; n < 2; ++n) _Pragma("unroll") for (int k = 0; k < 2; ++k) \
        acc[ai][bj][m][n] = __builtin_amdgcn_mfma_f32_16x16x32_bf16(Bt[n][k], At[m][k], acc[ai][bj][m][n], 0, 0, 0); __builtin_amdgcn_s_setprio(0); } while (0)
#define PG8_WAIT_V(n) asm volatile("s_waitcnt vmcnt(" #n ")" ::: "memory")
#define PG8_WAIT_L(n) asm volatile("s_waitcnt lgkmcnt(" #n ")" ::: "memory")
#define PG8_BAR __builtin_amdgcn_s_barrier()
#define PG8_SCHED __builtin_amdgcn_sched_barrier(0)
    Unit cur, nxt; int ui = 0;
    if (!S.next(0, cur)) return;
    f32x4 acc[2][2][4][2];
#pragma unroll
    for (int a = 0; a < 2; ++a)
#pragma unroll
        for (int b = 0; b < 2; ++b)
#pragma unroll
            for (int m = 0; m < 4; ++m)
#pragma unroll
                for (int n = 0; n < 2; ++n) acc[a][b][m][n] = (f32x4){0.f, 0.f, 0.f, 0.f};
    bf16x8 At[4][2], B0[2][2], B1[2][2];
    const char* cA = (const char*)g.A + (size_t)cur.pm * tstep; const char* cB = (const char*)g.Bt + (size_t)cur.pn * tstep;
    S.a_ready(cur);
    if constexpr (SP2) {
        PG8_STAGE(PG8_SB(0, 0), cB, voffB); PG8_STAGE(PG8_SB(0, 1), cB + hstep, voffB); PG8_STAGE(PG8_SA(0, 0), cA, voffA); PG8_STAGE(PG8_SA(0, 1), cA + hstep, voffA);
        if (wr == 1) PG8_BAR;
        PG8_WAIT_V(2); PG8_BAR;
        PG8_STAGE(PG8_SB(1, 0), cB + kstep, voffB); PG8_STAGE(PG8_SA(1, 0), cA + kstep, voffA); PG8_STAGE(PG8_SB(1, 1), cB + hstep + kstep, voffB);
        PG8_WAIT_V(6); PG8_BAR;
    } else {
        PG8_STAGE(PG8_SB(0, 0), cB, voffB); PG8_STAGE(PG8_SA(0, 0), cA, voffA); PG8_STAGE(PG8_SB(0, 1), cB + hstep, voffB); PG8_STAGE(PG8_SA(0, 1), cA + hstep, voffA);
        if (wr == 1) PG8_BAR;
        PG8_WAIT_V(4); PG8_BAR;
        PG8_STAGE(PG8_SB(1, 0), cB + kstep, voffB); PG8_STAGE(PG8_SA(1, 0), cA + kstep, voffA); PG8_STAGE(PG8_SB(1, 1), cB + hstep + kstep, voffB);
        PG8_WAIT_V(6); PG8_BAR;
    }
    for (;;) {
        const bool has_next = S.next(ui + 1, nxt);
        const char* nA = has_next ? (const char*)g.A + (size_t)nxt.pm * tstep : cA; const char* nB = has_next ? (const char*)g.Bt + (size_t)nxt.pn * tstep : cB;
        for (int t = 0; t < nt; t += 2) {
            const bool last = (t == nt - 2);
            const char* a1 = cA + (size_t)(t + 1) * kstep;
            const char* a2 = last ? nA : cA + (size_t)(t + 2) * kstep; const char* b2 = last ? nB : cB + (size_t)(t + 2) * kstep;
            const char* a3 = a2 + kstep; const char* b3 = b2 + kstep;
            if (last && has_next) S.a_ready(nxt);
            if constexpr (SP2) {
            PG8_LDB(B0, 0, 0); PG8_LDB(B1, 0, 1); PG8_SCHED; PG8_LDA(At, 0, 0); PG8_STAGE(PG8_SA(1, 1), a1 + hstep, voffA);
            PG8_WAIT_V(8); PG8_WAIT_L(0); PG8_BAR; PG8_MMA(0, 0, At, B0); PG8_MMA(0, 1, At, B1); PG8_BAR; PG8_SCHED;
            PG8_LDA(At, 0, 1); PG8_STAGE(PG8_SB(0, 0), b2, voffB); PG8_STAGE(PG8_SB(0, 1), b2 + hstep, voffB); PG8_STAGE(PG8_SA(0, 0), a2, voffA);
            PG8_WAIT_V(8); PG8_WAIT_L(0); PG8_BAR; PG8_MMA(1, 0, At, B0); PG8_MMA(1, 1, At, B1); PG8_BAR; PG8_SCHED;
            PG8_LDB(B0, 1, 0); PG8_LDB(B1, 1, 1); PG8_SCHED; PG8_LDA(At, 1, 0); PG8_STAGE(PG8_SA(0, 1), a2 + hstep, voffA);
            PG8_WAIT_V(8); PG8_WAIT_L(0); PG8_BAR; PG8_MMA(0, 0, At, B0); PG8_MMA(0, 1, At, B1); PG8_BAR; PG8_SCHED;
            PG8_LDA(At, 1, 1); PG8_STAGE(PG8_SB(1, 0), b3, voffB); PG8_STAGE(PG8_SB(1, 1), b3 + hstep, voffB); PG8_STAGE(PG8_SA(1, 0), a3, voffA);
            PG8_WAIT_V(8); PG8_WAIT_L(0); PG8_BAR; PG8_MMA(1, 0, At, B0); PG8_MMA(1, 1, At, B1); PG8_BAR; PG8_SCHED;
            } else {
            PG8_LDB(B0, 0, 0); PG8_SCHED; PG8_LDA(At, 0, 0); PG8_STAGE(PG8_SA(1, 1), a1 + hstep, voffA);
            PG8_WAIT_L(8); PG8_BAR; PG8_WAIT_L(0); PG8_MMA(0, 0, At, B0); PG8_BAR; PG8_SCHED;
            PG8_LDB(B1, 0, 1); PG8_STAGE(PG8_SB(0, 0), b2, voffB);
            PG8_BAR; PG8_WAIT_L(0); PG8_MMA(0, 1, At, B1); PG8_BAR;
            PG8_LDA(At, 0, 1); PG8_STAGE(PG8_SA(0, 0), a2, voffA);
            PG8_BAR; PG8_WAIT_L(0); PG8_MMA(1, 0, At, B0); PG8_BAR; PG8_SCHED;
            PG8_STAGE(PG8_SB(0, 1), b2 + hstep, voffB);
            PG8_WAIT_V(6); PG8_BAR; PG8_MMA(1, 1, At, B1); PG8_BAR;
            PG8_LDB(B0, 1, 0); PG8_SCHED; PG8_LDA(At, 1, 0); PG8_STAGE(PG8_SA(0, 1), a2 + hstep, voffA);
            PG8_WAIT_L(8); PG8_BAR; PG8_WAIT_L(0); PG8_MMA(0, 0, At, B0); PG8_BAR; PG8_SCHED;
            PG8_LDB(B1, 1, 1); PG8_STAGE(PG8_SB(1, 0), b3, voffB);
            PG8_BAR; PG8_WAIT_L(0); PG8_MMA(0, 1, At, B1); PG8_BAR;
            PG8_LDA(At, 1, 1); PG8_STAGE(PG8_SA(1, 0), a3, voffA);
            PG8_BAR; PG8_WAIT_L(0); PG8_MMA(1, 0, At, B0); PG8_BAR; PG8_SCHED;
            PG8_STAGE(PG8_SB(1, 1), b3 + hstep, voffB);
            PG8_WAIT_V(6); PG8_BAR; PG8_MMA(1, 1, At, B1); PG8_BAR;
            }
        }
        if constexpr (ALIGN_EPI) { if (wr == 0) PG8_BAR; }
        if constexpr (!Epi::AFTER_DRAIN) { E(acc, cur, wr, wc, fr, fq); S.done(cur); }
        if (!has_next) break;
#pragma unroll
        for (int a = 0; a < 2; ++a)
#pragma unroll
            for (int b = 0; b < 2; ++b)
#pragma unroll
                for (int m = 0; m < 4; ++m)
#pragma unroll
                    for (int n = 0; n < 2; ++n) acc[a][b][m][n] = (f32x4){0.f, 0.f, 0.f, 0.f};
        cur = nxt; cA = nA; cB = nB; ++ui;
        if constexpr (ALIGN_EPI) { if (wr == 1) PG8_BAR; }
    }
    PG8_WAIT_V(0);
    if constexpr (!ALIGN_EPI) { if (wr == 0) PG8_BAR; }
    PG8_BAR;
    if constexpr (Epi::AFTER_DRAIN) { E.fused(acc, cur, wr, wc, fr, fq, lds, wid, lane); S.done(cur); }
#undef PG8_SA
#undef PG8_SB
#undef PG8_STAGE
#undef PG8_LDA
#undef PG8_LDB
#undef PG8_MMA
#undef PG8_WAIT_V
#undef PG8_WAIT_L
#undef PG8_BAR
#undef PG8_SCHED
}
}

#define GAS __attribute__((address_space(1)))
#define LAS __attribute__((address_space(3)))
typedef unsigned short bf16;
typedef unsigned v4u __attribute__((ext_vector_type(4)));
typedef unsigned v2u __attribute__((ext_vector_type(2)));
typedef float f32x4 __attribute__((ext_vector_type(4)));
typedef short bf16x8 __attribute__((ext_vector_type(8)));
typedef short s16x4 __attribute__((ext_vector_type(4)));
#define LDS_WAIT() asm volatile("s_waitcnt lgkmcnt(0)" ::: "memory")

constexpr int NWAVES = 8;
constexpr int BATCH = 16, SEQ = 2048, D = 1024, FF = 2816, DIN = 2560, HD = 64, NH = 8, DA = 512, DC = 512, CK = 31;
constexpr int M = BATCH * SEQ;
constexpr float EPS = 1e-6f;
constexpr float LOG2E = 1.4426950408889634f;

constexpr int LDS_BYTES = 147456;

__device__ __forceinline__ unsigned f2bf(float f) { unsigned u = __builtin_bit_cast(unsigned, f); return (u + 0x7fffu + ((u >> 16) & 1u)) >> 16; }
__device__ __forceinline__ unsigned pk2(float lo, float hi) { return f2bf(lo) | (f2bf(hi) << 16); }
__device__ __forceinline__ float bf2f(unsigned short b) { return __builtin_bit_cast(float, (unsigned)b << 16); }
__device__ __forceinline__ float wave_sum(float v) {
#pragma unroll
    for (int o = 1; o < 64; o <<= 1) v += __shfl_xor(v, o);
    return v;
}

struct Args { const float* in[18]; float* out; unsigned char* ws; };

__device__ __forceinline__ void transpose_item(const float* W, int ldw, const float* gain, int k0, int sn0, bf16* WT, int K, int dn0, LAS float* scr, int lane, float wsc = 1.0f) {
    float wv[32];
#pragma unroll
    for (int i = 0; i < 32; ++i) wv[i] = __builtin_nontemporal_load(W + (size_t)(k0 + 2 * i + (lane >> 5)) * ldw + sn0 + (lane & 31));
    if (gain) {
        const float g0 = gain[k0 + (lane & 63)];
#pragma unroll
        for (int i = 0; i < 32; ++i) wv[i] *= __shfl(g0, 2 * i + (lane >> 5));
    }
#pragma unroll
    for (int i = 0; i < 32; ++i) scr[(2 * i + (lane >> 5)) * 33 + (lane & 31)] = wv[i] * wsc;
    LDS_WAIT(); asm volatile("" ::: "memory");
    const int c = lane & 7;
#pragma unroll
    for (int j = 0; j < 4; ++j) { const int n = (lane >> 3) + 8 * j; const LAS float* s = scr + (8 * c) * 33 + n;
        v4u o; o.x = pk2(s[0 * 33], s[1 * 33]); o.y = pk2(s[2 * 33], s[3 * 33]); o.z = pk2(s[4 * 33], s[5 * 33]); o.w = pk2(s[6 * 33], s[7 * 33]);
        *(v4u*)(WT + (size_t)(dn0 + n) * K + k0 + 8 * c) = o; }
    LDS_WAIT(); asm volatile("" ::: "memory");
}
__device__ __forceinline__ void gu_item(const float* Wg, const float* Wu, const float* gain, bf16* WT, int item, LAS float* scr, int lane) {
    constexpr int NNB = 5632 / 32; const int kb = item / NNB, nb = item % NNB, dn0 = 32 * nb, tile = dn0 >> 8, rr = dn0 & 255;
    const float* W = rr < 128 ? Wg : Wu; const int sn0 = tile * 128 + (rr & 127);
    transpose_item(W, FF, gain, 64 * kb, sn0, WT, D, dn0, scr, lane, rr < 128 ? -1.4426950408889634f : -0.6931471805599453f);
}
__device__ __forceinline__ void win_item(const float* W, const float* gain, bf16* WT, int item, LAS float* scr, int lane) {
    constexpr int NNB = DIN / 32; const int kb = item / NNB, nb = item % NNB, dn0 = 32 * nb, pn = dn0 >> 8, c = dn0 & 255;
    int sn0;
    if (pn < 4) { const int bj = c >> 7, wc = (c & 127) >> 5; sn0 = (pn >> 1) * 512 + ((pn & 1) * 4 + wc) * 64 + bj * 32; }
    else if (pn < 6) sn0 = 1024 + (pn - 4) * 256 + c;
    else sn0 = (c < 128 ? 1536 : 2048) + (pn - 6) * 128 + (c & 127);
    transpose_item(W, DIN, gain, 64 * kb, sn0, WT, D, dn0, scr, lane);
}
__device__ __forceinline__ void nat_item(const float* W, int K, int N, bf16* WT, int item, LAS float* scr, int lane) {
    const int nnb = N / 32, kb = item / nnb, nb = item % nnb;
    transpose_item(W, N, nullptr, 64 * kb, 32 * nb, WT, K, 32 * nb, scr, lane);
}
__device__ __forceinline__ void rms_row_to_bf16(const float* xrow, const float* gain, bf16* orow, int lane) {
    const f32x4* xr = (const f32x4*)xrow + lane; const f32x4* gr = (const f32x4*)gain + lane;
    f32x4 v[4]; float s = 0.f;
#pragma unroll
    for (int j = 0; j < 4; ++j) { v[j] = xr[64 * j]; s += (v[j].x * v[j].x + v[j].y * v[j].y) + (v[j].z * v[j].z + v[j].w * v[j].w); }
    const float rstd = 1.0f / sqrtf(wave_sum(s) * (1.f / D) + EPS);
    unsigned long long* o8 = (unsigned long long*)orow + lane;
#pragma unroll
    for (int j = 0; j < 4; ++j) { const f32x4 g = gr[64 * j]; o8[64 * j] = (unsigned long long)pk2(v[j].x * rstd * g.x, v[j].y * rstd * g.y) | ((unsigned long long)pk2(v[j].z * rstd * g.z, v[j].w * rstd * g.w) << 32); }
}

__device__ __forceinline__ void conv_phase(LAS unsigned char* lds, const bf16* G, const float* cw, const float* cb, const float* lng, const float* lnb, bf16* MIX, int bx, int ngrid, int tid) {
    constexpr int NU = BATCH * (SEQ / 32);
    LAS bf16* gl = (LAS bf16*)lds;
    LAS float* ys = (LAS float*)(lds + 65536);
    const int c = tid, wave = tid >> 6, lane = tid & 63;
    float w[CK];
#pragma unroll
    for (int k = 0; k < CK; ++k) w[k] = cw[k * DC + c];
    const float bias = cb[c];
    const f32x4 g0 = *(const f32x4*)(lng + lane * 8), g1 = *(const f32x4*)(lng + lane * 8 + 4), b0 = *(const f32x4*)(lnb + lane * 8), b1 = *(const f32x4*)(lnb + lane * 8 + 4);
    v4u pre[8];
#define CV_LOAD(u_) do { const int b_ = (u_) / (SEQ / 32), t0_ = ((u_) % (SEQ / 32)) * 32; \
        _Pragma("unroll") for (int i = 0; i < 8; ++i) { const int idx = tid + i * (NWAVES * 64), rr = idx >> 6, pc = idx & 63, t = t0_ - 30 + rr; \
            pre[i] = (v4u){0u, 0u, 0u, 0u}; if (idx < 62 * 64 && t >= 0) pre[i] = *(const v4u*)(G + ((size_t)b_ * SEQ + t) * DC + pc * 8); } } while (0)
    const bool xl = ngrid == 256; const int nj = xl ? 4 : (NU - bx + ngrid - 1) / ngrid;
#define CV_UNIT(j_) (xl ? (bx & 7) * 128 + (j_) * 32 + (bx >> 3) : bx + (j_) * ngrid)
    if (nj > 0) CV_LOAD(CV_UNIT(0));
    for (int j = 0; j < nj; ++j) { const int u = CV_UNIT(j);
        const int b = u / (SEQ / 32), t0 = (u % (SEQ / 32)) * 32; const size_t rowbase = (size_t)b * SEQ;
#pragma unroll
        for (int i = 0; i < 8; ++i) { const int idx = tid + i * (NWAVES * 64); if (idx < 62 * 64) *(LAS v4u*)(gl + (idx >> 6) * 512 + (idx & 63) * 8) = pre[i]; }
        __syncthreads();
        if (j + 1 < nj) CV_LOAD(CV_UNIT(j + 1));
        {
            float g[62];
#pragma unroll
            for (int j = 0; j < 62; ++j) g[j] = bf2f(gl[j * 512 + c]);
#pragma unroll
            for (int t = 0; t < 32; ++t) {
                float a0 = bias, a1 = 0.f;
#pragma unroll
                for (int k = 0; k < CK - 1; k += 2) { a0 += w[k] * g[t + k]; a1 += w[k + 1] * g[t + k + 1]; }
                a0 += w[CK - 1] * g[t + CK - 1];
                ys[t * 512 + c] = a0 + a1;
            }
        }
        __syncthreads();
#pragma unroll
        for (int i = 0; i < 4; ++i) { const int t = wave * 4 + i;
            const f32x4 v0 = *(const LAS f32x4*)(ys + t * 512 + lane * 8), v1 = *(const LAS f32x4*)(ys + t * 512 + lane * 8 + 4);
            const float mean = wave_sum((v0[0] + v0[1]) + (v0[2] + v0[3]) + (v1[0] + v1[1]) + (v1[2] + v1[3])) * (1.0f / DC);
            const f32x4 d0 = v0 - mean, d1 = v1 - mean;
            const float var = wave_sum((d0[0] * d0[0] + d0[1] * d0[1]) + (d0[2] * d0[2] + d0[3] * d0[3]) + (d1[0] * d1[0] + d1[1] * d1[1]) + (d1[2] * d1[2] + d1[3] * d1[3])) * (1.0f / DC);
            const float rstd = 1.0f / sqrtf(var + EPS);
            f32x4 y0 = d0 * rstd * g0 + b0, y1 = d1 * rstd * g1 + b1;
#pragma unroll
            for (int e = 0; e < 4; ++e) { y0[e] = y0[e] * pg8::sigm(y0[e]); y1[e] = y1[e] * pg8::sigm(y1[e]); }
            v4u o; o.x = pk2(y0[0], y0[1]); o.y = pk2(y0[2], y0[3]); o.z = pk2(y1[0], y1[1]); o.w = pk2(y1[2], y1[3]);
            *(v4u*)(MIX + (rowbase + t0 + t) * D + DA + lane * 8) = o; }
    }
#undef CV_LOAD
#undef CV_UNIT
    __syncthreads();
}

constexpr int VPITCH = 144;
constexpr int VTILE = 64 * VPITCH;
__device__ __forceinline__ s16x4 vtr(const LAS unsigned char* p) { return __builtin_bit_cast(s16x4, __builtin_amdgcn_ds_read_tr16_b64_v4i16((LAS s16x4*)p)); }
constexpr int SH_ROWS = 392, SH_V = SH_ROWS * 128, SH_ST = SH_V + SH_ROWS * VPITCH, ST_PITCH = 68, SH_ML = SH_ST + 128 * ST_PITCH * 4;
static_assert(SH_ML + 1024 <= 147456 - 64 && 8 * (VTILE + 8192) <= 147456 - 64, "attention LDS map");
template <int N> struct IntC { static constexpr int value = N; };
__device__ __forceinline__ void attn_unit(LAS unsigned char* lds, const bf16* Qn, const bf16* K1, const bf16* V1, bf16* MIX, int b, int h, int t0, int half, int wave, int tid) {
    const int lane = tid & 63, qi = lane & 15, kg = lane >> 4, r = 8 * half + wave;
    const int tr = t0 + r;
    const size_t rowbase = (size_t)b * SEQ;
    const int dqa = 16 * (qi >> 3) + (qi & 7), qfirst = t0 + 32 * wave + 8 * half;
    bf16x8 qf[2];
#pragma unroll
    for (int s = 0; s < 2; ++s) qf[s] = *(const bf16x8*)(Qn + (rowbase + qfirst + dqa) * DA + h * HD + 32 * s + 8 * kg);
    float m_run = -1e20f, l_part = 0.f;
    f32x4 o[4];
#pragma unroll
    for (int db = 0; db < 4; ++db) o[db] = (f32x4){0.f, 0.f, 0.f, 0.f};
    const size_t hb = (size_t)(b * NH + h) * SEQ * HD;
    const int krow0 = 8 * (qi >> 2) + (qi & 3);
    const int vroff = (8 * kg + (qi >> 2)) * VPITCH + (qi & 3) * 8;
    auto core = [&](auto ngc, const LAS unsigned char* kb, const LAS unsigned char* vb, int A, int lbn) __attribute__((always_inline)) {
        constexpr int NG = decltype(ngc)::value;
        const int hi = A - 8 * kg, lo = (A - 128 > lbn ? A - 128 : lbn) - 8 * kg;
        const unsigned wd = (unsigned)(hi - lo);
        bf16x8 kf[2 * NG][2];
#pragma unroll
        for (int tt = 0; tt < 2 * NG; ++tt)
#pragma unroll
            for (int s2 = 0; s2 < 2; ++s2) kf[tt][s2] = *(const LAS bf16x8*)(kb + (32 * (tt >> 1) + krow0 + 4 * (tt & 1)) * 128 + (((kg + 4 * s2) ^ ((krow0 + 4 * (tt & 1)) & 7)) << 4));
        f32x4 sc[2 * NG];
#pragma unroll
        for (int tt = 0; tt < 2 * NG; ++tt) { sc[tt] = (f32x4){0.f, 0.f, 0.f, 0.f};
            sc[tt] = __builtin_amdgcn_mfma_f32_16x16x32_bf16(kf[tt][0], qf[0], sc[tt], 0, 0, 0); sc[tt] = __builtin_amdgcn_mfma_f32_16x16x32_bf16(kf[tt][1], qf[1], sc[tt], 0, 0, 0); }
        float mx = -1e30f;
#pragma unroll
        for (int tt = 0; tt < 2 * NG; ++tt)
#pragma unroll
            for (int e = 0; e < 4; ++e) { const int c = 32 * (tt >> 1) + 4 * (tt & 1) + e; const bool ok = (unsigned)(c - lo) <= wd;
                sc[tt][e] = ok ? sc[tt][e] : -1e30f; mx = fmaxf(mx, sc[tt][e]); }
        mx = fmaxf(mx, __shfl_xor(mx, 16)); mx = fmaxf(mx, __shfl_xor(mx, 32));
        const float m_new = fmaxf(m_run, mx), alpha = __builtin_amdgcn_exp2f(m_run - m_new);
        m_run = m_new;
        float ps = 0.f;
#pragma unroll
        for (int tt = 0; tt < 2 * NG; ++tt)
#pragma unroll
            for (int e = 0; e < 4; ++e) { sc[tt][e] = __builtin_amdgcn_exp2f(sc[tt][e] - m_new); ps += sc[tt][e]; }
        l_part = l_part * alpha + ps;
#pragma unroll
        for (int db = 0; db < 4; ++db) o[db] = o[db] * alpha;
#pragma unroll
        for (int g = 0; g < NG; ++g) {
            v4u pw; pw.x = pg8::cvt_pk_bf16(sc[2 * g][0], sc[2 * g][1]); pw.y = pg8::cvt_pk_bf16(sc[2 * g][2], sc[2 * g][3]); pw.z = pg8::cvt_pk_bf16(sc[2 * g + 1][0], sc[2 * g + 1][1]); pw.w = pg8::cvt_pk_bf16(sc[2 * g + 1][2], sc[2 * g + 1][3]);
            const bf16x8 pf = __builtin_bit_cast(bf16x8, pw);
#pragma unroll
            for (int db = 0; db < 4; ++db) { const s16x4 vlo = vtr(vb + vroff + g * 32 * VPITCH + db * 32), vhi = vtr(vb + vroff + g * 32 * VPITCH + db * 32 + 4 * VPITCH);
                const bf16x8 vf = (bf16x8){vlo[0], vlo[1], vlo[2], vlo[3], vhi[0], vhi[1], vhi[2], vhi[3]};
                o[db] = __builtin_amdgcn_mfma_f32_16x16x32_bf16(vf, pf, o[db], 0, 0, 0); } }
        asm volatile("s_waitcnt lgkmcnt(0)" ::: "memory");
    };
    LAS unsigned char* vl = lds + wave * (VTILE + 8192);
    LAS unsigned char* kl = vl + VTILE;
    LAS unsigned char* vw = vl + (lane >> 3) * VPITCH + (lane & 7) * 16;
    LAS unsigned char* kw = kl + (lane >> 3) * 128 + ((((lane & 7) ^ ((lane >> 3) & 7))) << 4);
#define AT_SH(pt) ((pt) == 1 ? 2 : 4)
    int plo1 = 0, plo2 = 0;
    while ((tr >> 2) - 128 + 64 * plo1 + 63 < 0) ++plo1;
    while ((tr >> 4) - 128 + 64 * plo2 + 63 < 0) ++plo2;
#define AT_LOAD(KF, VV, pt, pp) do { const int sh_ = AT_SH(pt), lmax_ = (SEQ >> sh_) - 1, lb_ = (tr >> sh_) - 128 + 64 * (pp); \
        const int res_ = tr & ((1 << sh_) - 1); const bf16* Kp_ = K1 + hb; const bf16* Vp_ = V1 + hb;     \
        _Pragma("unroll") for (int i = 0; i < 8; ++i) { int l_ = lb_ + 8 * i + (lane >> 3); l_ = l_ < 0 ? 0 : (l_ > lmax_ ? lmax_ : l_); const int to_ = ((l_ << sh_) + res_) * HD + (lane & 7) * 8; \
            KF[i] = *(const v4u*)(Kp_ + to_); VV[i] = *(const v4u*)(Vp_ + to_); } } while (0)
#define AT_ADV(pt, pp, hs) do { if (hs) { ++pp; if (pp >= 3) { ++pt; if (pt < 3) pp = plo2; else hs = false; } } } while (0)
    int lpat = 1, lp = plo1, cpat = 1, cp = plo1; bool lhas = true;
    v4u k0[8], k1[8], w0[8], w1[8];
    {
        const int row0 = tid >> 3, ch = tid & 7;
        const bf16* kg1 = K1 + hb + ch * 8; const bf16* vg1 = V1 + hb + ch * 8;
        LAS unsigned char* const skw = lds + row0 * 128 + ((ch ^ (row0 & 7)) << 4);
        LAS unsigned char* const svw = lds + SH_V + row0 * VPITCH + ch * 16;
        v4u kreg[7], vreg[7];
#pragma unroll
        for (int i = 0; i < 7; ++i) { int tk = t0 - 128 + row0 + 64 * i; tk = tk < 0 ? 0 : (tk > SEQ - 1 ? SEQ - 1 : tk);
            if (i < 6 || row0 < SH_ROWS - 384) { kreg[i] = *(const v4u*)(kg1 + tk * HD); vreg[i] = *(const v4u*)(vg1 + tk * HD); } }
        __syncthreads();
#pragma unroll
        for (int i = 0; i < 7; ++i)
            if (i < 6 || row0 < SH_ROWS - 384) { *(LAS v4u*)(skw + i * 8192) = kreg[i]; *(LAS v4u*)(svw + i * 64 * VPITCH) = vreg[i]; }
        asm volatile("" ::: "memory");
        AT_LOAD(k0, w0, lpat, lp); AT_ADV(lpat, lp, lhas);
        AT_LOAD(k1, w1, lpat, lp); AT_ADV(lpat, lp, lhas);
        __syncthreads();
        const int R0 = 32 * wave + 8 * half;
#pragma unroll
        for (int s = 0; s < 2; ++s) { const int kt = qfirst - 128 + 64 * s;
            if (kt + 63 >= 0) core(IntC<2>{}, lds + (R0 + 64 * s) * 128, lds + SH_V + (R0 + 64 * s) * VPITCH, dqa + 128 - 64 * s, -kt); }
        core(IntC<1>{}, lds + (R0 + 128) * 128, lds + SH_V + (R0 + 128) * VPITCH, dqa, -qfirst);
        float lq = l_part; lq += __shfl_xor(lq, 16); lq += __shfl_xor(lq, 32);
        LAS float* So = (LAS float*)(lds + SH_ST); LAS float* Sm = (LAS float*)(lds + SH_ML); LAS float* Sl = Sm + 128;
        const int qla = 16 * wave + qi, qlb = 8 * qi + wave;
#pragma unroll
        for (int db = 0; db < 4; ++db) *(LAS f32x4*)(So + qla * ST_PITCH + 16 * db + 4 * kg) = o[db];
        if (kg == 0) { Sm[qla] = m_run; Sl[qla] = lq; }
#pragma unroll
        for (int s = 0; s < 2; ++s) qf[s] = *(const bf16x8*)(Qn + (rowbase + tr + 16 * qi) * DA + h * HD + 32 * s + 8 * kg);
        __syncthreads();
#pragma unroll
        for (int db = 0; db < 4; ++db) o[db] = *(const LAS f32x4*)(So + qlb * ST_PITCH + 16 * db + 4 * kg);
        m_run = Sm[qlb]; l_part = kg == 0 ? Sl[qlb] : 0.f;
        __syncthreads();
    }
    auto compute = [&](const v4u (&kk)[8], const v4u (&vv)[8], int pat, int p) __attribute__((always_inline)) {
        const int sh = AT_SH(pat);
#pragma unroll
        for (int i = 0; i < 8; ++i) *(LAS v4u*)(vw + 8 * i * VPITCH) = vv[i];
#pragma unroll
        for (int i = 0; i < 8; ++i) *(LAS v4u*)(kw + 8 * i * 128) = kk[i];
        asm volatile("s_waitcnt lgkmcnt(0)" ::: "memory");
        const int A = ((16 >> sh) * qi) + 128 - 64 * p, lbn = 128 - 64 * p - (tr >> sh);
        if (pat == 2 && p == 2) core(IntC<1>{}, kl, vl, A, lbn); else core(IntC<2>{}, kl, vl, A, lbn);
    };
#define AT_STEP(KC, WC) { compute(KC, WC, cpat, cp); bool chas = true; AT_ADV(cpat, cp, chas); if (!chas) break; AT_LOAD(KC, WC, lpat, lp); AT_ADV(lpat, lp, lhas); }
    for (;;) {
        AT_STEP(k0, w0)
        AT_STEP(k1, w1)
    }
#undef AT_STEP
#undef AT_ADV
#undef AT_LOAD
#undef AT_SH
    float l = l_part; l += __shfl_xor(l, 16); l += __shfl_xor(l, 32);
    const float inv = 1.0f / l;
    bf16* orow = MIX + (rowbase + tr + 16 * qi) * D + h * HD + 4 * kg;
#pragma unroll
    for (int db = 0; db < 4; ++db) { v2u w; w.x = pk2(o[db][0] * inv, o[db][1] * inv); w.y = pk2(o[db][2] * inv, o[db][3] * inv); *(v2u*)(orow + 16 * db) = w; }
}

#define XB_TMO      128
#define XB_XCNT(j)  (256  + 64 * (j))
#define XB_XSUB(j)  (1280 + 64 * (j))
#define XB_XGEN(j)  (2304 + 64 * (j))
#define XB_TOP      3328
#define XB_TOPGEN   3392
#define XCD_BAR_WORDS 3456
#define XB_SPIN_CAP (1u << 18)

__device__ __forceinline__ unsigned xb_ld(unsigned* p)              { return __hip_atomic_load(p, __ATOMIC_RELAXED, __HIP_MEMORY_SCOPE_AGENT); }
__device__ __forceinline__ unsigned xb_add(unsigned* p, unsigned v) { return __hip_atomic_fetch_add(p, v, __ATOMIC_RELAXED, __HIP_MEMORY_SCOPE_AGENT); }
__device__ __forceinline__ unsigned xb_xcc_id() { return (unsigned)__builtin_amdgcn_s_getreg((3 << 11) | 20) & 0xFu; }
#define XB_SPIN(cond, bar) do { unsigned _sp = 0; while (cond) { __builtin_amdgcn_s_sleep(1); \
    if ((++_sp & 255u) == 0u) { if (xb_ld(&(bar)[XB_TMO])) break; if (_sp > XB_SPIN_CAP) { atomicAdd(&(bar)[XB_TMO], 1u); break; } } } } while (0)

struct XcdBarrier {
    unsigned* bar; unsigned x;
    volatile LAS unsigned* st;
};

__device__ __forceinline__ XcdBarrier xcd_barrier_post(unsigned* bar, volatile LAS unsigned* st) {
    XcdBarrier b; b.bar = bar; b.x = xb_xcc_id(); b.st = st;
    if (threadIdx.x == 0) (void)xb_add(&bar[XB_XCNT(b.x)], 1u);
    return b;
}
__device__ __forceinline__ void xcd_barrier_complete(unsigned* bar, unsigned x, unsigned& nloc, unsigned& nx) {
    const unsigned G = gridDim.x * gridDim.y * gridDim.z;
    unsigned sum, cnt, mine, sp = 0u;
    for (;;) {
        sum = 0u; cnt = 0u; mine = 0u;
#pragma unroll
        for (unsigned j = 0; j < 16; ++j) { const unsigned c = xb_ld(&bar[XB_XCNT(j)]); sum += c; cnt += (c > 0u) ? 1u : 0u; mine = (j == x) ? c : mine; }
        if (sum == G) break;
        __builtin_amdgcn_s_sleep(1);
        if ((++sp & 255u) == 0u) { if (xb_ld(&bar[XB_TMO])) break; if (sp > XB_SPIN_CAP) { atomicAdd(&bar[XB_TMO], 1u); break; } }
    }
    nloc = mine > 0u ? mine : 1u; nx = cnt > 0u ? cnt : 1u;
}

__device__ __forceinline__ void xcd_barrier(const XcdBarrier& b) {
    asm volatile("s_waitcnt vmcnt(0)" ::: "memory");
    __syncthreads();
    if (threadIdx.x == 0) {
        unsigned* bar = b.bar;
        __builtin_amdgcn_s_waitcnt(0);
        unsigned nloc = b.st[0], nx = b.st[1];
        if (nloc == 0u) { xcd_barrier_complete(bar, b.x, nloc, nx); b.st[0] = nloc; b.st[1] = nx; }
        const unsigned old = xb_add(&bar[XB_XSUB(b.x)], 1u);
        const unsigned gen = old / nloc;
        if (old + 1u == (gen + 1u) * nloc) {
            __builtin_amdgcn_fence(__ATOMIC_RELEASE, "agent");
            asm volatile("s_waitcnt vmcnt(0)" ::: "memory");
            const unsigned og = xb_add(&bar[XB_TOP], 1u);
            const unsigned tg = og / nx;
            if (og + 1u == (tg + 1u) * nx) xb_add(&bar[XB_TOPGEN], 1u);
            else XB_SPIN(xb_ld(&bar[XB_TOPGEN]) == tg, bar);
            __builtin_amdgcn_fence(__ATOMIC_ACQUIRE, "agent");
            xb_add(&bar[XB_XGEN(b.x)], 1u);
            asm volatile("s_waitcnt vmcnt(0)" ::: "memory");
        } else {
            XB_SPIN(xb_ld(&bar[XB_XGEN(b.x)]) == gen, bar);
            __builtin_amdgcn_fence(__ATOMIC_ACQUIRE, "agent");
            asm volatile("s_waitcnt vmcnt(0)" ::: "memory");
        }
    }
    __syncthreads();
}

__global__ void __launch_bounds__(NWAVES * 64, 2) mega_fwd(Args args) {
    extern __shared__ __attribute__((aligned(16))) unsigned char lds_raw[];
    cg::grid_group grid = cg::this_grid();
    LAS unsigned char* lds = (LAS unsigned char*)lds_raw;
    const int tid = threadIdx.x, lane = tid & 63, wave = __builtin_amdgcn_readfirstlane(tid >> 6);
    const int G = gridDim.x, bx = blockIdx.x;
    unsigned char* ws = args.ws;
    const float* x = args.in[0];
    const float *ffn1_norm = args.in[1], *w1g = args.in[2], *w1u = args.in[3], *w1d = args.in[4], *mix_norm = args.in[5], *w_in = args.in[6], *q_norm = args.in[7], *k_norm = args.in[8];
    const float *conv_w = args.in[9], *conv_b = args.in[10], *ln_g = args.in[11], *ln_b = args.in[12], *w_out = args.in[13], *ffn2_norm = args.in[14], *w2g = args.in[15], *w2u = args.in[16], *w2d = args.in[17];
    float* out = args.out;
    volatile LAS unsigned* bst = (volatile LAS unsigned*)(lds + LDS_BYTES - 64);
    if (tid < 2) bst[tid] = 0u;
    __syncthreads();
    const XcdBarrier xbar = xcd_barrier_post((unsigned*)ws, bst);
    if (ws == nullptr) grid.sync();
    bf16 *Wgu1 = (bf16*)(ws + WS_WGU1), *Wd1 = (bf16*)(ws + WS_WD1), *Win = (bf16*)(ws + WS_WIN), *Wout = (bf16*)(ws + WS_WOUT), *Wgu2 = (bf16*)(ws + WS_WGU2), *Wd2 = (bf16*)(ws + WS_WD2);
    float *SL1 = (float*)(ws + WS_SL1), *SL2 = (float*)(ws + WS_SL2);
    bf16 *AB = (bf16*)(ws + WS_AB), *HMID = (bf16*)(ws + WS_HMID), *Qb = (bf16*)(ws + WS_Q), *Kb = (bf16*)(ws + WS_K), *Vb = (bf16*)(ws + WS_V), *Gb = (bf16*)(ws + WS_G), *MIX = (bf16*)(ws + WS_MIX);

    {
        LAS float* scr = (LAS float*)(lds + wave * 16384);
        const int gw = bx * NWAVES + wave, NGW = G * NWAVES;
        constexpr int I_GU = 16 * (5632 / 32), I_D = 44 * 32, I_IN = 16 * (DIN / 32), I_O = 16 * 32;
        constexpr int NITEMS = 2 * I_GU + 2 * I_D + I_IN + I_O;
        for (int it = gw; it < NITEMS; it += NGW) {
            int r = it;
            if (r < I_GU) { gu_item(w1g, w1u, nullptr, Wgu1, r, scr, lane); continue; } r -= I_GU;
            if (r < I_GU) { gu_item(w2g, w2u, ffn2_norm, Wgu2, r, scr, lane); continue; } r -= I_GU;
            if (r < I_D) { nat_item(w1d, FF, D, Wd1, r, scr, lane); continue; } r -= I_D;
            if (r < I_D) { nat_item(w2d, FF, D, Wd2, r, scr, lane); continue; } r -= I_D;
            if (r < I_IN) { win_item(w_in, mix_norm, Win, r, scr, lane); continue; } r -= I_IN;
            nat_item(w_out, D, D, Wout, r, scr, lane);
        }
        {
            const f32x4* gr = (const f32x4*)ffn1_norm + lane;
            int m = gw;
            for (; m + 3 * NGW < M; m += 4 * NGW) {
                f32x4 v[4][4]; float sq[4];
#pragma unroll
                for (int q = 0; q < 4; ++q) { const f32x4* xr = (const f32x4*)(x + (size_t)(m + q * NGW) * D) + lane;
#pragma unroll
                    for (int j = 0; j < 4; ++j) v[q][j] = __builtin_nontemporal_load(xr + 64 * j); }
#pragma unroll
                for (int q = 0; q < 4; ++q) { float t = 0.f;
#pragma unroll
                    for (int j = 0; j < 4; ++j) t += (v[q][j].x * v[q][j].x + v[q][j].y * v[q][j].y) + (v[q][j].z * v[q][j].z + v[q][j].w * v[q][j].w);
                    sq[q] = 1.0f / sqrtf(wave_sum(t) * (1.f / D) + EPS); }
#pragma unroll
                for (int q = 0; q < 4; ++q) { unsigned long long* o8 = (unsigned long long*)(AB + (size_t)(m + q * NGW) * D) + lane; const float rstd = sq[q];
#pragma unroll
                    for (int j = 0; j < 4; ++j) { const f32x4 g = gr[64 * j]; o8[64 * j] = (unsigned long long)pk2(v[q][j].x * rstd * g.x, v[q][j].y * rstd * g.y) | ((unsigned long long)pk2(v[q][j].z * rstd * g.z, v[q][j].w * rstd * g.w) << 32); } }
            }
            for (; m < M; m += NGW) rms_row_to_bf16(x + (size_t)m * D, ffn1_norm, AB + (size_t)m * D, lane);
        }
    }
    xcd_barrier(xbar);
    {
        pg8::Gemm g{AB, Wgu1, M, 2 * FF, D}; pg8::StaticOrder S; S.init(M, 2 * FF, G, bx);
        pg8::EpiSwiglu<false> E{HMID, nullptr};
        pg8::gemm_phase<pg8::EpiSwiglu<false>, pg8::StaticOrder, true, true>(lds, g, S, E);
    }
    xcd_barrier(xbar);
    {
        pg8::Gemm g{HMID, Wd1, M, D, FF}; pg8::StaticOrder S; S.init(M, D, G, bx); S.rev = 1;
        pg8::EpiRes<0> E{x, AB, nullptr, SL1, 0.5f};
        pg8::gemm_phase<pg8::EpiRes<0>, pg8::StaticOrder, true, true>(lds, g, S, E);
    }
    xcd_barrier(xbar);
    {
        pg8::Gemm g{AB, Win, M, DIN, D}; pg8::StaticOrder S; S.init(M, DIN, G, bx);
        pg8::EpiWin E{ws, SL1, q_norm, k_norm};
        pg8::gemm_phase<pg8::EpiWin, pg8::StaticOrder, true, true>(lds, g, S, E);
    }
    xcd_barrier(xbar);
    {
        int tid4 = threadIdx.x; asm volatile("" : "+v"(tid4)); const int lane4 = tid4 & 63;
        conv_phase(lds, Gb, conv_w, conv_b, ln_g, ln_b, MIX, bx, G, tid4);
        if (G == 256) {
            const int xq = bx & 7, w = bx >> 3;
            for (int j = 0; j < 8; ++j) { const int bh = xq + 8 * (2 * j + (w >> 4)), span = (((w & 15) >> 1) + j) & 7, half = w & 1;
                attn_unit(lds, Qb, Kb, Vb, MIX, bh >> 3, bh & 7, span * 256, half, wave, tid4); }
        } else
        for (int u = bx; u < 8 * 256; u += G) { const int span = u >> 8, rem = u & 255, bh = rem >> 1, half = rem & 1;
            attn_unit(lds, Qb, Kb, Vb, MIX, bh >> 3, bh & 7, span * 256, half, wave, tid4); }
    }
    xcd_barrier(xbar);
    {
        pg8::Gemm g{MIX, Wout, M, D, D}; pg8::StaticOrder S; S.init(M, D, G, bx);
        pg8::EpiRes<1> E{nullptr, AB, nullptr, SL2, 1.0f};
        pg8::gemm_phase<pg8::EpiRes<1>, pg8::StaticOrder, true, true>(lds, g, S, E);
    }
    xcd_barrier(xbar);
    {
        pg8::Gemm g{AB, Wgu2, M, 2 * FF, D}; pg8::StaticOrder S; S.init(M, 2 * FF, G, bx);
        pg8::EpiSwiglu<true> E{HMID, SL2};
        pg8::gemm_phase<pg8::EpiSwiglu<true>, pg8::StaticOrder, true, true>(lds, g, S, E);
    }
    xcd_barrier(xbar);
    {
        pg8::Gemm g{HMID, Wd2, M, D, FF}; pg8::StaticOrder S; S.init(M, D, G, bx); S.rev = 1;
        pg8::EpiRes<2> E{nullptr, AB, out, nullptr, 0.5f};
        pg8::gemm_phase<pg8::EpiRes<2>, pg8::StaticOrder, true, true>(lds, g, S, E);
    }
}

extern "C" void kernel_launch(void* const* d_in, const int* in_sizes, int n_in, void* d_out, int out_size, void* d_ws, size_t ws_size, hipStream_t stream) {
    static int grid_blocks = 0;
    if (grid_blocks == 0) {
        if (n_in != 18 || out_size != M * D || ws_size < WS_END) { fprintf(stderr, "kernel_launch: unexpected shapes (n_in %d out %d ws %zu)\n", n_in, out_size, ws_size); grid_blocks = -1; return; }
        int dev = 0, cus = 0, per_cu = 0;
        (void)hipGetDevice(&dev);
        (void)hipDeviceGetAttribute(&cus, hipDeviceAttributeMultiprocessorCount, dev);
        (void)hipFuncSetAttribute((const void*)mega_fwd, hipFuncAttributeMaxDynamicSharedMemorySize, LDS_BYTES);
        (void)hipOccupancyMaxActiveBlocksPerMultiprocessor(&per_cu, (const void*)mega_fwd, NWAVES * 64, LDS_BYTES);
        if (per_cu < 1) { fprintf(stderr, "kernel_launch: occupancy query reports %d blocks per CU\n", per_cu); per_cu = 1; }
        grid_blocks = cus * 1;
    }
    if (grid_blocks < 0) return;
    if (hipMemsetAsync(d_ws, 0, XCD_BAR_WORDS * sizeof(unsigned), stream) != hipSuccess) { fprintf(stderr, "kernel_launch: hipMemsetAsync of the barrier words failed\n"); return; }
    Args a{};
    for (int i = 0; i < 18; ++i) a.in[i] = (const float*)d_in[i];
    a.out = (float*)d_out; a.ws = (unsigned char*)d_ws;
    void* kargs[] = {&a};
    hipError_t e = hipLaunchCooperativeKernel((const void*)mega_fwd, dim3(grid_blocks), dim3(NWAVES * 64), kargs, LDS_BYTES, stream);
    if (e != hipSuccess) fprintf(stderr, "cooperative launch failed: %s (grid %d)\n", hipGetErrorString(e), grid_blocks);
}
```

```cpp
#include <hip/hip_runtime.h>
#include <hip/hip_cooperative_groups.h>
#include <cstdio>
#include <cstdint>
namespace cg = cooperative_groups;
constexpr size_t MiB = 1u << 20;
constexpr size_t WS_WGU1 = 1 * MiB;
constexpr size_t WS_WD1 = 13 * MiB;
constexpr size_t WS_WIN = 19 * MiB;
constexpr size_t WS_WOUT = 24 * MiB;
constexpr size_t WS_WGU2 = 26 * MiB;
constexpr size_t WS_WD2 = 38 * MiB;
constexpr size_t WS_SL1 = 44 * MiB;
constexpr size_t WS_SL2 = 46 * MiB;
constexpr size_t WS_AB = 48 * MiB;
constexpr size_t WS_HMID = 112 * MiB;
constexpr size_t WS_Q = WS_HMID, WS_K = WS_HMID + 32 * MiB, WS_V = WS_HMID + 64 * MiB, WS_G = WS_HMID + 96 * MiB, WS_MIX = WS_HMID + 128 * MiB;
constexpr size_t WS_END = WS_HMID + 192 * MiB;
namespace pg8 {
#define PG8_LAS __attribute__((address_space(3)))
typedef unsigned short bf16_t;
typedef short bf16x8 __attribute__((ext_vector_type(8)));
typedef float f32x4 __attribute__((ext_vector_type(4)));
typedef unsigned u32x4 __attribute__((ext_vector_type(4)));
constexpr int BM = 256, BK = 64, HALF = 128, HTB = HALF * BK * 2  , STAGE_BYTES = 8 * HTB, NXCD = 8, WGM = 2;

__host__ __device__ __forceinline__ int lds_byte(int r, int c) { const int st = (r >> 4) * 2 + (c >> 5), rr = r & 15, cc = c & 31, ob = rr * 64 + cc * 2; return st * 1024 + (ob ^ (((ob >> 9) & 1) << 5)); }
__host__ __device__ __forceinline__ void stage_rc(int b, int& R, int& C) { const int st = b / 1024, sb = b % 1024, swz = sb ^ (((sb >> 9) & 1) << 5); R = (st >> 1) * 16 + swz / 64; C = (st & 1) * 32 + (swz % 64) / 2; }
__host__ __device__ __forceinline__ int perm32(int rho) { const int n = rho >> 4, i = rho & 15; return 8 * (i >> 2) + 4 * n + (i & 3); }

struct Unit { int pm, pn; };
struct Gemm { const bf16_t* A; const bf16_t* Bt; int M, N, K; };

struct StaticOrder {
    int nM, nN, nwg, G, c, rev;
    __host__ __device__ void init(int M, int N, int G_, int c_) { nM = M / BM; nN = N / BM; nwg = nM * nN; G = G_; c = c_; rev = 0; }
    __host__ __device__ bool next(int i, Unit& u) const {
        const long L = (long)i * G + c; if (L >= nwg) return false;
        int wgid = (int)L; { const int q = nwg / NXCD, r = nwg % NXCD, xcd = wgid % NXCD, off = wgid / NXCD; wgid = (xcd < r ? xcd * (q + 1) : r * (q + 1) + (xcd - r) * q) + off; }
        const int nig = WGM * nN, gid = wgid / nig, fm = gid * WGM, gsz = (nM - fm) < WGM ? (nM - fm) : WGM;
        u.pm = fm + ((wgid % nig) % gsz); u.pn = (wgid % nig) / gsz; if (rev) u.pm = nM - 1 - u.pm; return true;
    }
    __device__ __forceinline__ void a_ready(const Unit&) const {}
    __device__ __forceinline__ void done(const Unit&) const {}
};

__device__ __forceinline__ unsigned cvt_pk_bf16(float lo, float hi) { unsigned r; asm volatile("v_cvt_pk_bf16_f32 %0, %1, %2" : "=v"(r) : "v"(lo), "v"(hi)); return r; }
typedef float f32x2 __attribute__((ext_vector_type(2)));
constexpr float LOG2E = 1.4426950408889634f;
__device__ __forceinline__ float sigm(float g) { return __builtin_amdgcn_rcpf(1.0f + __builtin_amdgcn_exp2f(-g * LOG2E)); }
__device__ __forceinline__ void rows_rstd(float (&rs)[2][4], const float* slots, int row0, int fq) {
    f32x4 sl[2][4];
#pragma unroll
    for (int ai = 0; ai < 2; ++ai)
#pragma unroll
        for (int m = 0; m < 4; ++m) sl[ai][m] = *(const f32x4*)(slots + (size_t)(row0 + ai * HALF + m * 16) * 16 + 4 * fq);
#pragma unroll
    for (int ai = 0; ai < 2; ++ai)
#pragma unroll
        for (int m = 0; m < 4; ++m) { float t = (sl[ai][m][0] + sl[ai][m][1]) + (sl[ai][m][2] + sl[ai][m][3]); t += __shfl_xor(t, 16); t += __shfl_xor(t, 32);
            rs[ai][m] = __builtin_amdgcn_rsqf(t * (1.0f / 1024.0f) + 1e-6f); }
}
template <bool SCALE> struct EpiSwiglu {
    static constexpr bool PERM = true, AFTER_DRAIN = false;
    bf16_t* O; const float* slots;
    __device__ __forceinline__ void operator()(const f32x4 (&acc)[2][2][4][2], const Unit& u, int wr, int wc, int fr, int fq) const {
        const int row0 = u.pm * BM + wr * 64 + fr, col0 = u.pn * 128 + wc * 32 + 8 * fq;
        float rsa[2][4]; if (SCALE) rows_rstd(rsa, slots, row0, fq);
#pragma unroll
        for (int ai = 0; ai < 2; ++ai)
#pragma unroll
            for (int m = 0; m < 4; ++m) {
                const int row = row0 + ai * HALF + m * 16; float rs = 1.f; if (SCALE) rs = rsa[ai][m];
                u32x4 w;
#pragma unroll
                for (int n = 0; n < 2; ++n) { const f32x4 g = acc[ai][0][m][n] * rs, uu = acc[ai][1][m][n] * rs; f32x4 o;
#pragma unroll
                    for (int e = 0; e < 4; ++e) o[e] = g[e] * uu[e] * __builtin_amdgcn_rcpf(1.0f + __builtin_amdgcn_exp2f(g[e]));
                    w[2 * n] = cvt_pk_bf16(o[0], o[1]); w[2 * n + 1] = cvt_pk_bf16(o[2], o[3]); }
                *(u32x4*)(O + (size_t)row * 2816 + col0) = w; }
    }
};
template <int MODE> struct EpiRes {
    static constexpr bool PERM = true, AFTER_DRAIN = false;
    const float* x; bf16_t* hb; float* out; float* slots; float alpha;
    static __device__ __forceinline__ f32x4 lo4(u32x4 w) { return (f32x4){__builtin_bit_cast(float, w.x << 16), __builtin_bit_cast(float, w.x & 0xffff0000u), __builtin_bit_cast(float, w.y << 16), __builtin_bit_cast(float, w.y & 0xffff0000u)}; }
    static __device__ __forceinline__ f32x4 hi4(u32x4 w) { return (f32x4){__builtin_bit_cast(float, w.z << 16), __builtin_bit_cast(float, w.z & 0xffff0000u), __builtin_bit_cast(float, w.w << 16), __builtin_bit_cast(float, w.w & 0xffff0000u)}; }
    __device__ __forceinline__ void finish(f32x4 o0, f32x4 o1, size_t off, float& ss) const {
        if (MODE == 2) { *(f32x4*)(out + off) = o0; *(f32x4*)(out + off + 4) = o1; }
        else { u32x4 w; w.x = cvt_pk_bf16(o0[0], o0[1]); w.y = cvt_pk_bf16(o0[2], o0[3]); w.z = cvt_pk_bf16(o1[0], o1[1]); w.w = cvt_pk_bf16(o1[2], o1[3]);
            *(u32x4*)(hb + off) = w;
            ss += (o0[0] * o0[0] + o0[1] * o0[1]) + (o0[2] * o0[2] + o0[3] * o0[3]) + (o1[0] * o1[0] + o1[1] * o1[1]) + (o1[2] * o1[2] + o1[3] * o1[3]); }
    }
    __device__ __forceinline__ void operator()(const f32x4 (&acc)[2][2][4][2], const Unit& u, int wr, int wc, int fr, int fq) const {
        const int row0 = u.pm * BM + wr * 64 + fr, col0 = u.pn * BM + wc * 32 + 8 * fq;
        if (MODE == 0) {
#pragma unroll
            for (int ai = 0; ai < 2; ++ai) {
                f32x4 b[4][2][2];
#pragma unroll
                for (int m = 0; m < 4; ++m)
#pragma unroll
                    for (int bj = 0; bj < 2; ++bj) { const size_t off = (size_t)(row0 + ai * HALF + m * 16) * 1024 + col0 + bj * HALF; b[m][bj][0] = *(const f32x4*)(x + off); b[m][bj][1] = *(const f32x4*)(x + off + 4); }
#pragma unroll
                for (int m = 0; m < 4; ++m) { const int row = row0 + ai * HALF + m * 16; float ss = 0.f;
#pragma unroll
                    for (int bj = 0; bj < 2; ++bj) finish(b[m][bj][0] + acc[ai][bj][m][0] * alpha, b[m][bj][1] + acc[ai][bj][m][1] * alpha, (size_t)row * 1024 + col0 + bj * HALF, ss);
                    ss += __shfl_xor(ss, 16); ss += __shfl_xor(ss, 32); if (fq == 0) slots[(size_t)row * 16 + u.pn * 4 + wc] = ss; } }
        } else {
            u32x4 b[2][4][2];
#pragma unroll
            for (int ai = 0; ai < 2; ++ai)
#pragma unroll
                for (int m = 0; m < 4; ++m)
#pragma unroll
                    for (int bj = 0; bj < 2; ++bj) b[ai][m][bj] = *(const u32x4*)(hb + (size_t)(row0 + ai * HALF + m * 16) * 1024 + col0 + bj * HALF);
#pragma unroll
            for (int ai = 0; ai < 2; ++ai)
#pragma unroll
                for (int m = 0; m < 4; ++m) { const int row = row0 + ai * HALF + m * 16; float ss = 0.f;
#pragma unroll
                    for (int bj = 0; bj < 2; ++bj) finish(lo4(b[ai][m][bj]) + acc[ai][bj][m][0] * alpha, hi4(b[ai][m][bj]) + acc[ai][bj][m][1] * alpha, (size_t)row * 1024 + col0 + bj * HALF, ss);
                    if (MODE == 1) { ss += __shfl_xor(ss, 16); ss += __shfl_xor(ss, 32); if (fq == 0) slots[(size_t)row * 16 + u.pn * 4 + wc] = ss; } }
        }
    }
};
struct EpiWin {
    static constexpr bool PERM = true, AFTER_DRAIN = false;
    unsigned char* ws; const float* slots; const float *qg, *kg;
    static __device__ __forceinline__ unsigned kvoff(int sh, int bh, int t) { return (unsigned)((bh * 2048 + (t & ((1 << sh) - 1)) * (2048 >> sh) + (t >> sh)) * 64); }
    __device__ __forceinline__ void operator()(const f32x4 (&acc)[2][2][4][2], const Unit& u, int wr, int wc, int fr, int fq) const {
        const int row0 = u.pm * BM + wr * 64 + fr, pn = u.pn;
        float rsa[2][4]; rows_rstd(rsa, slots, row0, fq);
        if (pn < 4) {
            const bool isq = pn < 2; const float* gn = isq ? qg : kg; const float sc = isq ? 0.125f * LOG2E : 1.0f;
            const int head = (pn & 1) * 4 + wc, hcol = head * 64 + 8 * fq;
            f32x4 gv[2][2];
#pragma unroll
            for (int bj = 0; bj < 2; ++bj)
#pragma unroll
                for (int n = 0; n < 2; ++n) gv[bj][n] = *(const f32x4*)(gn + bj * 32 + 8 * fq + 4 * n) * sc;
#pragma unroll
            for (int ai = 0; ai < 2; ++ai)
#pragma unroll
                for (int m = 0; m < 4; ++m) {
                    const int row = row0 + ai * HALF + m * 16; const float rs = rsa[ai][m];
                    f32x4 v[2][2]; float ss = 0.f;
#pragma unroll
                    for (int bj = 0; bj < 2; ++bj)
#pragma unroll
                        for (int n = 0; n < 2; ++n) { v[bj][n] = acc[ai][bj][m][n] * rs; const f32x4 q = v[bj][n] * v[bj][n]; ss += (q[0] + q[1]) + (q[2] + q[3]); }
                    ss += __shfl_xor(ss, 16); ss += __shfl_xor(ss, 32);
                    const float rinv = __builtin_amdgcn_rsqf(ss * (1.0f / 64.0f) + 1e-6f);
#pragma unroll
                    for (int bj = 0; bj < 2; ++bj) { const f32x4 o0 = v[bj][0] * rinv * gv[bj][0], o1 = v[bj][1] * rinv * gv[bj][1];
                        u32x4 w; w.x = cvt_pk_bf16(o0[0], o0[1]); w.y = cvt_pk_bf16(o0[2], o0[3]); w.z = cvt_pk_bf16(o1[0], o1[1]); w.w = cvt_pk_bf16(o1[2], o1[3]);
                        if (isq) *(u32x4*)((bf16_t*)(ws + WS_Q) + (size_t)row * 512 + hcol + bj * 32) = w;
                        else { const int bh = (row >> 11) * 8 + head, t = row & 2047, dd = bj * 32 + 8 * fq; bf16_t* K1 = (bf16_t*)(ws + WS_K) + dd;
                            *(u32x4*)(K1 + kvoff(0, bh, t)) = w; } } }
        } else if (pn < 6) {
            const int col0 = (pn - 4) * BM + wc * 32 + 8 * fq;
#pragma unroll
            for (int ai = 0; ai < 2; ++ai)
#pragma unroll
                for (int m = 0; m < 4; ++m) {
                    const int row = row0 + ai * HALF + m * 16; const float rs = rsa[ai][m];
#pragma unroll
                    for (int bj = 0; bj < 2; ++bj) { const f32x4 o0 = acc[ai][bj][m][0] * rs, o1 = acc[ai][bj][m][1] * rs;
                        u32x4 w; w.x = cvt_pk_bf16(o0[0], o0[1]); w.y = cvt_pk_bf16(o0[2], o0[3]); w.z = cvt_pk_bf16(o1[0], o1[1]); w.w = cvt_pk_bf16(o1[2], o1[3]);
                        const int col = col0 + bj * HALF, bh = (row >> 11) * 8 + (col >> 6), t = row & 2047, dd = col & 63;
                        bf16_t* V1 = (bf16_t*)(ws + WS_V) + dd;
                        *(u32x4*)(V1 + kvoff(0, bh, t)) = w; } }
        } else {
            const int col0 = (pn - 6) * 128 + wc * 32 + 8 * fq;
#pragma unroll
            for (int ai = 0; ai < 2; ++ai)
#pragma unroll
                for (int m = 0; m < 4; ++m) {
                    const int row = row0 + ai * HALF + m * 16; const float rs = rsa[ai][m];
                    u32x4 w;
#pragma unroll
                    for (int n = 0; n < 2; ++n) { const f32x4 a = acc[ai][0][m][n] * rs, g = acc[ai][1][m][n] * rs; f32x4 o;
#pragma unroll
                        for (int e = 0; e < 4; ++e) o[e] = a[e] * sigm(g[e]);
                        w[2 * n] = cvt_pk_bf16(o[0], o[1]); w[2 * n + 1] = cvt_pk_bf16(o[2], o[3]); }
                    *(u32x4*)((bf16_t*)(ws + WS_G) + (size_t)row * 512 + col0) = w; }
        }
    }
};

template <class Epi, class Sched, bool ALIGN_EPI = false, bool SP2 = false>
__device__ __forceinline__ void gemm_phase(PG8_LAS unsigned char* lds, const Gemm g, const Sched& S, const Epi& E) {
    int tid_ = threadIdx.x; asm volatile("" : "+v"(tid_));
    const int tid = tid_, wid = __builtin_amdgcn_readfirstlane(tid >> 6), lane = tid & 63, wr = wid >> 2, wc = wid & 3, fr = lane & 15, fq = lane >> 4;
    const int K = g.K, nt = K / BK;
    unsigned voffA[2], voffB[2];
#pragma unroll
    for (int i = 0; i < 2; ++i) { int R, C; stage_rc(tid * 16 + i * 8192, R, C); const int Rb = Epi::PERM ? ((R & ~31) + perm32(R & 31)) : R;
        voffA[i] = (unsigned)(R * K + C) * 2u; voffB[i] = (unsigned)(Rb * K + C) * 2u; }
    const size_t kstep = (size_t)(BK * 2);
    const size_t hstep = (size_t)HALF * K * 2;
    const size_t tstep = 2 * hstep;
    const unsigned ldsw = (unsigned)wid * 1024u;
    const int aoff = lds_byte(wr * 64 + fr, fq * 8), boff = lds_byte(wc * 32 + fr, fq * 8);
#define PG8_SA(b, h) (((b) * 2 + (h)) * HTB)
#define PG8_SB(b, h) ((4 + (b) * 2 + (h)) * HTB)
#define PG8_STAGE(bufoff, gbase, voff) do { _Pragma("unroll") for (int _i = 0; _i < 2; ++_i) \
        __builtin_amdgcn_global_load_lds((const unsigned*)((const char*)(gbase) + (voff)[_i]), (PG8_LAS unsigned*)(lds + (bufoff) + ldsw + _i * 8192), 16, 0, 0); } while (0)
#define PG8_LDA(dst, b, h) do { _Pragma("unroll") for (int m = 0; m < 4; ++m) _Pragma("unroll") for (int k = 0; k < 2; ++k) dst[m][k] = *(const PG8_LAS bf16x8*)(lds + PG8_SA(b, h) + aoff + m * 2048 + k * 1024); } while (0)
#define PG8_LDB(dst, b, h) do { _Pragma("unroll") for (int n = 0; n < 2; ++n) _Pragma("unroll") for (int k = 0; k < 2; ++k) dst[n][k] = *(const PG8_LAS bf16x8*)(lds + PG8_SB(b, h) + boff + n * 2048 + k * 1024); } while (0)
#define PG8_MMA(ai, bj, At, Bt) do { __builtin_amdgcn_s_setprio(1); _Pragma("unroll") for (int m = 0; m < 4; ++m) _Pragma("unroll") for (int n = 0; n < 2; ++n) _Pragma("unroll") for (int k = 0; k < 2; ++k) \
        acc[ai][bj][m][n] = __builtin_amdgcn_mfma_f32_16x16x32_bf16(Bt[n][k], At[m][k], acc[ai][bj][m][n], 0, 0, 0); __builtin_amdgcn_s_setprio(0); } while (0)
#define PG8_WAIT_V(n) asm volatile("s_waitcnt vmcnt(" #n ")" ::: "memory")
#define PG8_WAIT_L(n) asm volatile("s_waitcnt lgkmcnt(" #n ")" ::: "memory")
#define PG8_BAR __builtin_amdgcn_s_barrier()
#define PG8_SCHED __builtin_amdgcn_sched_barrier(0)
    Unit cur, nxt; int ui = 0;
    if (!S.next(0, cur)) return;
    f32x4 acc[2][2][4][2];
#pragma unroll
    for (int a = 0; a < 2; ++a)
#pragma unroll
        for (int b = 0; b < 2; ++b)
#pragma unroll
            for (int m = 0; m < 4; ++m)
#pragma unroll
                for (int n = 0; n < 2; ++n) acc[a][b][m][n] = (f32x4){0.f, 0.f, 0.f, 0.f};
    bf16x8 At[4][2], B0[2][2], B1[2][2];
    const char* cA = (const char*)g.A + (size_t)cur.pm * tstep; const char* cB = (const char*)g.Bt + (size_t)cur.pn * tstep;
    S.a_ready(cur);
    if constexpr (SP2) {
        PG8_STAGE(PG8_SB(0, 0), cB, voffB); PG8_STAGE(PG8_SB(0, 1), cB + hstep, voffB); PG8_STAGE(PG8_SA(0, 0), cA, voffA); PG8_STAGE(PG8_SA(0, 1), cA + hstep, voffA);
        if (wr == 1) PG8_BAR;
        PG8_WAIT_V(2); PG8_BAR;
        PG8_STAGE(PG8_SB(1, 0), cB + kstep, voffB); PG8_STAGE(PG8_SA(1, 0), cA + kstep, voffA); PG8_STAGE(PG8_SB(1, 1), cB + hstep + kstep, voffB);
        PG8_WAIT_V(6); PG8_BAR;
    } else {
        PG8_STAGE(PG8_SB(0, 0), cB, voffB); PG8_STAGE(PG8_SA(0, 0), cA, voffA); PG8_STAGE(PG8_SB(0, 1), cB + hstep, voffB); PG8_STAGE(PG8_SA(0, 1), cA + hstep, voffA);
        if (wr == 1) PG8_BAR;
        PG8_WAIT_V(4); PG8_BAR;
        PG8_STAGE(PG8_SB(1, 0), cB + kstep, voffB); PG8_STAGE(PG8_SA(1, 0), cA + kstep, voffA); PG8_STAGE(PG8_SB(1, 1), cB + hstep + kstep, voffB);
        PG8_WAIT_V(6); PG8_BAR;
    }
    for (;;) {
        const bool has_next = S.next(ui + 1, nxt);
        const char* nA = has_next ? (const char*)g.A + (size_t)nxt.pm * tstep : cA; const char* nB = has_next ? (const char*)g.Bt + (size_t)nxt.pn * tstep : cB;
        for (int t = 0; t < nt; t += 2) {
            const bool last = (t == nt - 2);
            const char* a1 = cA + (size_t)(t + 1) * kstep;
            const char* a2 = last ? nA : cA + (size_t)(t + 2) * kstep; const char* b2 = last ? nB : cB + (size_t)(t + 2) * kstep;
            const char* a3 = a2 + kstep; const char* b3 = b2 + kstep;
            if (last && has_next) S.a_ready(nxt);
            if constexpr (SP2) {
            PG8_LDB(B0, 0, 0); PG8_LDB(B1, 0, 1); PG8_SCHED; PG8_LDA(At, 0, 0); PG8_STAGE(PG8_SA(1, 1), a1 + hstep, voffA);
            PG8_WAIT_V(8); PG8_WAIT_L(0); PG8_BAR; PG8_MMA(0, 0, At, B0); PG8_MMA(0, 1, At, B1); PG8_BAR; PG8_SCHED;
            PG8_LDA(At, 0, 1); PG8_STAGE(PG8_SB(0, 0), b2, voffB); PG8_STAGE(PG8_SB(0, 1), b2 + hstep, voffB); PG8_STAGE(PG8_SA(0, 0), a2, voffA);
            PG8_WAIT_V(8); PG8_WAIT_L(0); PG8_BAR; PG8_MMA(1, 0, At, B0); PG8_MMA(1, 1, At, B1); PG8_BAR; PG8_SCHED;
            PG8_LDB(B0, 1, 0); PG8_LDB(B1, 1, 1); PG8_SCHED; PG8_LDA(At, 1, 0); PG8_STAGE(PG8_SA(0, 1), a2 + hstep, voffA);
            PG8_WAIT_V(8); PG8_WAIT_L(0); PG8_BAR; PG8_MMA(0, 0, At, B0); PG8_MMA(0, 1, At, B1); PG8_BAR; PG8_SCHED;
            PG8_LDA(At, 1, 1); PG8_STAGE(PG8_SB(1, 0), b3, voffB); PG8_STAGE(PG8_SB(1, 1), b3 + hstep, voffB); PG8_STAGE(PG8_SA(1, 0), a3, voffA);
            PG8_WAIT_V(8); PG8_WAIT_L(0); PG8_BAR; PG8_MMA(1, 0, At, B0); PG8_MMA(1, 1, At, B1); PG8_BAR; PG8_SCHED;
            } else {
            PG8_LDB(B0, 0, 0); PG8_SCHED; PG8_LDA(At, 0, 0); PG8_STAGE(PG8_SA(1, 1), a1 + hstep, voffA);
            PG8_WAIT_L(8); PG8_BAR; PG8_WAIT_L(0); PG8_MMA(0, 0, At, B0); PG8_BAR; PG8_SCHED;
            PG8_LDB(B1, 0, 1); PG8_STAGE(PG8_SB(0, 0), b2, voffB);
            PG8_BAR; PG8_WAIT_L(0); PG8_MMA(0, 1, At, B1); PG8_BAR;
            PG8_LDA(At, 0, 1); PG8_STAGE(PG8_SA(0, 0), a2, voffA);
            PG8_BAR; PG8_WAIT_L(0); PG8_MMA(1, 0, At, B0); PG8_BAR; PG8_SCHED;
            PG8_STAGE(PG8_SB(0, 1), b2 + hstep, voffB);
            PG8_WAIT_V(6); PG8_BAR; PG8_MMA(1, 1, At, B1); PG8_BAR;
            PG8_LDB(B0, 1, 0); PG8_SCHED; PG8_LDA(At, 1, 0); PG8_STAGE(PG8_SA(0, 1), a2 + hstep, voffA);
            PG8_WAIT_L(8); PG8_BAR; PG8_WAIT_L(0); PG8_MMA(0, 0, At, B0); PG8_BAR; PG8_SCHED;
            PG8_LDB(B1, 1, 1); PG8_STAGE(PG8_SB(1, 0), b3, voffB);
            PG8_BAR; PG8_WAIT_L(0); PG8_MMA(0, 1, At, B1); PG8_BAR;
            PG8_LDA(At, 1, 1); PG8_STAGE(PG8_SA(1, 0), a3, voffA);
            PG8_BAR; PG8_WAIT_L(0); PG8_MMA(1, 0, At, B0); PG8_BAR; PG8_SCHED;
            PG8_STAGE(PG8_SB(1, 1), b3 + hstep, voffB);
            PG8_WAIT_V(6); PG8_BAR; PG8_MMA(1, 1, At, B1); PG8_BAR;
            }
        }
        if constexpr (ALIGN_EPI) { if (wr == 0) PG8_BAR; }
        if constexpr (!Epi::AFTER_DRAIN) { E(acc, cur, wr, wc, fr, fq); S.done(cur); }
        if (!has_next) break;
#pragma unroll
        for (int a = 0; a < 2; ++a)
#pragma unroll
            for (int b = 0; b < 2; ++b)
#pragma unroll
                for (int m = 0; m < 4; ++m)
#pragma unroll
                    for (int n = 0; n < 2; ++n) acc[a][b][m][n] = (f32x4){0.f, 0.f, 0.f, 0.f};
        cur = nxt; cA = nA; cB = nB; ++ui;
        if constexpr (ALIGN_EPI) { if (wr == 1) PG8_BAR; }
    }
    PG8_WAIT_V(0);
    if constexpr (!ALIGN_EPI) { if (wr == 0) PG8_BAR; }
    PG8_BAR;
    if constexpr (Epi::AFTER_DRAIN) { E.fused(acc, cur, wr, wc, fr, fq, lds, wid, lane); S.done(cur); }
#undef PG8_SA
#undef PG8_SB
#undef PG8_STAGE
#undef PG8_LDA
#undef PG8_LDB
#undef PG8_MMA
#undef PG8_WAIT_V
#undef PG8_WAIT_L
#undef PG8_BAR
#undef PG8_SCHED
}
}

#define GAS __attribute__((address_space(1)))
#define LAS __attribute__((address_space(3)))
typedef unsigned short bf16;
typedef unsigned v4u __attribute__((ext_vector_type(4)));
typedef unsigned v2u __attribute__((ext_vector_type(2)));
typedef float f32x4 __attribute__((ext_vector_type(4)));
typedef short bf16x8 __attribute__((ext_vector_type(8)));
typedef short s16x4 __attribute__((ext_vector_type(4)));
#define LDS_WAIT() asm volatile("s_waitcnt lgkmcnt(0)" ::: "memory")

constexpr int NWAVES = 8;
constexpr int BATCH = 16, SEQ = 2048, D = 1024, FF = 2816, DIN = 2560, HD = 64, NH = 8, DA = 512, DC = 512, CK = 31;
constexpr int M = BATCH * SEQ;
constexpr float EPS = 1e-6f;
constexpr float LOG2E = 1.4426950408889634f;

constexpr int LDS_BYTES = 147456;

__device__ __forceinline__ unsigned f2bf(float f) { unsigned u = __builtin_bit_cast(unsigned, f); return (u + 0x7fffu + ((u >> 16) & 1u)) >> 16; }
__device__ __forceinline__ unsigned pk2(float lo, float hi) { return f2bf(lo) | (f2bf(hi) << 16); }
__device__ __forceinline__ float bf2f(unsigned short b) { return __builtin_bit_cast(float, (unsigned)b << 16); }
__device__ __forceinline__ float wave_sum(float v) {
#pragma unroll
    for (int o = 1; o < 64; o <<= 1) v += __shfl_xor(v, o);
    return v;
}

struct Args { const float* in[18]; float* out; unsigned char* ws; };

__device__ __forceinline__ void transpose_item(const float* W, int ldw, const float* gain, int k0, int sn0, bf16* WT, int K, int dn0, LAS float* scr, int lane, float wsc = 1.0f) {
    float wv[32];
#pragma unroll
    for (int i = 0; i < 32; ++i) wv[i] = __builtin_nontemporal_load(W + (size_t)(k0 + 2 * i + (lane >> 5)) * ldw + sn0 + (lane & 31));
    if (gain) {
        const float g0 = gain[k0 + (lane & 63)];
#pragma unroll
        for (int i = 0; i < 32; ++i) wv[i] *= __shfl(g0, 2 * i + (lane >> 5));
    }
#pragma unroll
    for (int i = 0; i < 32; ++i) scr[(2 * i + (lane >> 5)) * 33 + (lane & 31)] = wv[i] * wsc;
    LDS_WAIT(); asm volatile("" ::: "memory");
    const int c = lane & 7;
#pragma unroll
    for (int j = 0; j < 4; ++j) { const int n = (lane >> 3) + 8 * j; const LAS float* s = scr + (8 * c) * 33 + n;
        v4u o; o.x = pk2(s[0 * 33], s[1 * 33]); o.y = pk2(s[2 * 33], s[3 * 33]); o.z = pk2(s[4 * 33], s[5 * 33]); o.w = pk2(s[6 * 33], s[7 * 33]);
        *(v4u*)(WT + (size_t)(dn0 + n) * K + k0 + 8 * c) = o; }
    LDS_WAIT(); asm volatile("" ::: "memory");
}
__device__ __forceinline__ void gu_item(const float* Wg, const float* Wu, const float* gain, bf16* WT, int item, LAS float* scr, int lane) {
    constexpr int NNB = 5632 / 32; const int kb = item / NNB, nb = item % NNB, dn0 = 32 * nb, tile = dn0 >> 8, rr = dn0 & 255;
    const float* W = rr < 128 ? Wg : Wu; const int sn0 = tile * 128 + (rr & 127);
    transpose_item(W, FF, gain, 64 * kb, sn0, WT, D, dn0, scr, lane, rr < 128 ? -1.4426950408889634f : -0.6931471805599453f);
}
__device__ __forceinline__ void win_item(const float* W, const float* gain, bf16* WT, int item, LAS float* scr, int lane) {
    constexpr int NNB = DIN / 32; const int kb = item / NNB, nb = item % NNB, dn0 = 32 * nb, pn = dn0 >> 8, c = dn0 & 255;
    int sn0;
    if (pn < 4) { const int bj = c >> 7, wc = (c & 127) >> 5; sn0 = (pn >> 1) * 512 + ((pn & 1) * 4 + wc) * 64 + bj * 32; }
    else if (pn < 6) sn0 = 1024 + (pn - 4) * 256 + c;
    else sn0 = (c < 128 ? 1536 : 2048) + (pn - 6) * 128 + (c & 127);
    transpose_item(W, DIN, gain, 64 * kb, sn0, WT, D, dn0, scr, lane);
}
__device__ __forceinline__ void nat_item(const float* W, int K, int N, bf16* WT, int item, LAS float* scr, int lane) {
    const int nnb = N / 32, kb = item / nnb, nb = item % nnb;
    transpose_item(W, N, nullptr, 64 * kb, 32 * nb, WT, K, 32 * nb, scr, lane);
}
__device__ __forceinline__ void rms_row_to_bf16(const float* xrow, const float* gain, bf16* orow, int lane) {
    const f32x4* xr = (const f32x4*)xrow + lane; const f32x4* gr = (const f32x4*)gain + lane;
    f32x4 v[4]; float s = 0.f;
#pragma unroll
    for (int j = 0; j < 4; ++j) { v[j] = xr[64 * j]; s += (v[j].x * v[j].x + v[j].y * v[j].y) + (v[j].z * v[j].z + v[j].w * v[j].w); }
    const float rstd = 1.0f / sqrtf(wave_sum(s) * (1.f / D) + EPS);
    unsigned long long* o8 = (unsigned long long*)orow + lane;
#pragma unroll
    for (int j = 0; j < 4; ++j) { const f32x4 g = gr[64 * j]; o8[64 * j] = (unsigned long long)pk2(v[j].x * rstd * g.x, v[j].y * rstd * g.y) | ((unsigned long long)pk2(v[j].z * rstd * g.z, v[j].w * rstd * g.w) << 32); }
}

__device__ __forceinline__ void conv_phase(LAS unsigned char* lds, const bf16* G, const float* cw, const float* cb, const float* lng, const float* lnb, bf16* MIX, int bx, int ngrid, int tid) {
    constexpr int NU = BATCH * (SEQ / 32);
    LAS bf16* gl = (LAS bf16*)lds;
    LAS float* ys = (LAS float*)(lds + 65536);
    const int c = tid, wave = tid >> 6, lane = tid & 63;
    float w[CK];
#pragma unroll
    for (int k = 0; k < CK; ++k) w[k] = cw[k * DC + c];
    const float bias = cb[c];
    const f32x4 g0 = *(const f32x4*)(lng + lane * 8), g1 = *(const f32x4*)(lng + lane * 8 + 4), b0 = *(const f32x4*)(lnb + lane * 8), b1 = *(const f32x4*)(lnb + lane * 8 + 4);
    v4u pre[8];
#define CV_LOAD(u_) do { const int b_ = (u_) / (SEQ / 32), t0_ = ((u_) % (SEQ / 32)) * 32; \
        _Pragma("unroll") for (int i = 0; i < 8; ++i) { const int idx = tid + i * (NWAVES * 64), rr = idx >> 6, pc = idx & 63, t = t0_ - 30 + rr; \
            pre[i] = (v4u){0u, 0u, 0u, 0u}; if (idx < 62 * 64 && t >= 0) pre[i] = __builtin_nontemporal_load((const v4u*)(G + ((size_t)b_ * SEQ + t) * DC + pc * 8)); } } while (0)
    const bool xl = ngrid == 256; const int nj = xl ? 4 : (NU - bx + ngrid - 1) / ngrid;
#define CV_UNIT(j_) (xl ? (bx & 7) * 128 + (j_) * 32 + (bx >> 3) : bx + (j_) * ngrid)
    if (nj > 0) CV_LOAD(CV_UNIT(0));
    for (int j = 0; j < nj; ++j) { const int u = CV_UNIT(j);
        const int b = u / (SEQ / 32), t0 = (u % (SEQ / 32)) * 32; const size_t rowbase = (size_t)b * SEQ;
#pragma unroll
        for (int i = 0; i < 8; ++i) { const int idx = tid + i * (NWAVES * 64); if (idx < 62 * 64) *(LAS v4u*)(gl + (idx >> 6) * 512 + (idx & 63) * 8) = pre[i]; }
        __syncthreads();
        if (j + 1 < nj) CV_LOAD(CV_UNIT(j + 1));
        {
            float g[62];
#pragma unroll
            for (int j = 0; j < 62; ++j) g[j] = bf2f(gl[j * 512 + c]);
#pragma unroll
            for (int t = 0; t < 32; ++t) {
                float a0 = bias, a1 = 0.f;
#pragma unroll
                for (int k = 0; k < CK - 1; k += 2) { a0 += w[k] * g[t + k]; a1 += w[k + 1] * g[t + k + 1]; }
                a0 += w[CK - 1] * g[t + CK - 1];
                ys[t * 512 + c] = a0 + a1;
            }
        }
        __syncthreads();
#pragma unroll
        for (int i = 0; i < 4; ++i) { const int t = wave * 4 + i;
            const f32x4 v0 = *(const LAS f32x4*)(ys + t * 512 + lane * 8), v1 = *(const LAS f32x4*)(ys + t * 512 + lane * 8 + 4);
            const float mean = wave_sum((v0[0] + v0[1]) + (v0[2] + v0[3]) + (v1[0] + v1[1]) + (v1[2] + v1[3])) * (1.0f / DC);
            const f32x4 d0 = v0 - mean, d1 = v1 - mean;
            const float var = wave_sum((d0[0] * d0[0] + d0[1] * d0[1]) + (d0[2] * d0[2] + d0[3] * d0[3]) + (d1[0] * d1[0] + d1[1] * d1[1]) + (d1[2] * d1[2] + d1[3] * d1[3])) * (1.0f / DC);
            const float rstd = 1.0f / sqrtf(var + EPS);
            f32x4 y0 = d0 * rstd * g0 + b0, y1 = d1 * rstd * g1 + b1;
#pragma unroll
            for (int e = 0; e < 4; ++e) { y0[e] = y0[e] * pg8::sigm(y0[e]); y1[e] = y1[e] * pg8::sigm(y1[e]); }
            v4u o; o.x = pk2(y0[0], y0[1]); o.y = pk2(y0[2], y0[3]); o.z = pk2(y1[0], y1[1]); o.w = pk2(y1[2], y1[3]);
            *(v4u*)(MIX + (rowbase + t0 + t) * D + DA + lane * 8) = o; }
    }
#undef CV_LOAD
#undef CV_UNIT
    __syncthreads();
}

constexpr int VPITCH = 144;
constexpr int VTILE = 64 * VPITCH;
__device__ __forceinline__ s16x4 vtr(const LAS unsigned char* p) { return __builtin_bit_cast(s16x4, __builtin_amdgcn_ds_read_tr16_b64_v4i16((LAS s16x4*)p)); }
constexpr int SH_ROWS = 392, SH_V = SH_ROWS * 128, SH_ST = SH_V + SH_ROWS * VPITCH, ST_PITCH = 68, SH_ML = SH_ST + 128 * ST_PITCH * 4;
static_assert(SH_ML + 1024 <= 147456 - 64 && 8 * (VTILE + 8192) <= 147456 - 64, "attention LDS map");
template <int N> struct IntC { static constexpr int value = N; };
__device__ __forceinline__ void attn_unit(LAS unsigned char* lds, const bf16* Qn, const bf16* K1, const bf16* V1, bf16* MIX, int b, int h, int t0, int half, int wave, int tid) {
    const int lane = tid & 63, qi = lane & 15, kg = lane >> 4, r = 8 * half + wave;
    const int tr = t0 + r;
    const size_t rowbase = (size_t)b * SEQ;
    const int dqa = 16 * (qi >> 3) + (qi & 7), qfirst = t0 + 32 * wave + 8 * half;
    bf16x8 qf[2];
#pragma unroll
    for (int s = 0; s < 2; ++s) qf[s] = *(const bf16x8*)(Qn + (rowbase + qfirst + dqa) * DA + h * HD + 32 * s + 8 * kg);
    float m_run = -1e20f, l_part = 0.f;
    f32x4 o[4];
#pragma unroll
    for (int db = 0; db < 4; ++db) o[db] = (f32x4){0.f, 0.f, 0.f, 0.f};
    const size_t hb = (size_t)(b * NH + h) * SEQ * HD;
    const int krow0 = 8 * (qi >> 2) + (qi & 3);
    const int vroff = (8 * kg + (qi >> 2)) * VPITCH + (qi & 3) * 8;
    auto core = [&](auto ngc, const LAS unsigned char* kb, const LAS unsigned char* vb, int A, int lbn) __attribute__((always_inline)) {
        constexpr int NG = decltype(ngc)::value;
        const int hi = A - 8 * kg, lo = (A - 128 > lbn ? A - 128 : lbn) - 8 * kg;
        const unsigned wd = (unsigned)(hi - lo);
        bf16x8 kf[2 * NG][2];
#pragma unroll
        for (int tt = 0; tt < 2 * NG; ++tt)
#pragma unroll
            for (int s2 = 0; s2 < 2; ++s2) kf[tt][s2] = *(const LAS bf16x8*)(kb + (32 * (tt >> 1) + krow0 + 4 * (tt & 1)) * 128 + (((kg + 4 * s2) ^ ((krow0 + 4 * (tt & 1)) & 7)) << 4));
        f32x4 sc[2 * NG];
#pragma unroll
        for (int tt = 0; tt < 2 * NG; ++tt) { sc[tt] = (f32x4){0.f, 0.f, 0.f, 0.f};
            sc[tt] = __builtin_amdgcn_mfma_f32_16x16x32_bf16(kf[tt][0], qf[0], sc[tt], 0, 0, 0); sc[tt] = __builtin_amdgcn_mfma_f32_16x16x32_bf16(kf[tt][1], qf[1], sc[tt], 0, 0, 0); }
        float mx = -1e30f;
#pragma unroll
        for (int tt = 0; tt < 2 * NG; ++tt)
#pragma unroll
            for (int e = 0; e < 4; ++e) { const int c = 32 * (tt >> 1) + 4 * (tt & 1) + e; const bool ok = (unsigned)(c - lo) <= wd;
                sc[tt][e] = ok ? sc[tt][e] : -1e30f; mx = fmaxf(mx, sc[tt][e]); }
        mx = fmaxf(mx, __shfl_xor(mx, 16)); mx = fmaxf(mx, __shfl_xor(mx, 32));
        const float m_new = fmaxf(m_run, mx), alpha = __builtin_amdgcn_exp2f(m_run - m_new);
        m_run = m_new;
        float ps = 0.f;
#pragma unroll
        for (int tt = 0; tt < 2 * NG; ++tt)
#pragma unroll
            for (int e = 0; e < 4; ++e) { sc[tt][e] = __builtin_amdgcn_exp2f(sc[tt][e] - m_new); ps += sc[tt][e]; }
        l_part = l_part * alpha + ps;
#pragma unroll
        for (int db = 0; db < 4; ++db) o[db] = o[db] * alpha;
#pragma unroll
        for (int g = 0; g < NG; ++g) {
            v4u pw; pw.x = pg8::cvt_pk_bf16(sc[2 * g][0], sc[2 * g][1]); pw.y = pg8::cvt_pk_bf16(sc[2 * g][2], sc[2 * g][3]); pw.z = pg8::cvt_pk_bf16(sc[2 * g + 1][0], sc[2 * g + 1][1]); pw.w = pg8::cvt_pk_bf16(sc[2 * g + 1][2], sc[2 * g + 1][3]);
            const bf16x8 pf = __builtin_bit_cast(bf16x8, pw);
#pragma unroll
            for (int db = 0; db < 4; ++db) { const s16x4 vlo = vtr(vb + vroff + g * 32 * VPITCH + db * 32), vhi = vtr(vb + vroff + g * 32 * VPITCH + db * 32 + 4 * VPITCH);
                const bf16x8 vf = (bf16x8){vlo[0], vlo[1], vlo[2], vlo[3], vhi[0], vhi[1], vhi[2], vhi[3]};
                o[db] = __builtin_amdgcn_mfma_f32_16x16x32_bf16(vf, pf, o[db], 0, 0, 0); } }
        asm volatile("s_waitcnt lgkmcnt(0)" ::: "memory");
    };
    LAS unsigned char* vl = lds + wave * (VTILE + 8192);
    LAS unsigned char* kl = vl + VTILE;
    LAS unsigned char* vw = vl + (lane >> 3) * VPITCH + (lane & 7) * 16;
    LAS unsigned char* kw = kl + (lane >> 3) * 128 + ((((lane & 7) ^ ((lane >> 3) & 7))) << 4);
#define AT_SH(pt) ((pt) == 1 ? 2 : 4)
    int plo1 = 0, plo2 = 0;
    while ((tr >> 2) - 128 + 64 * plo1 + 63 < 0) ++plo1;
    while ((tr >> 4) - 128 + 64 * plo2 + 63 < 0) ++plo2;
#define AT_LOAD(KF, VV, pt, pp) do { const int sh_ = AT_SH(pt), lmax_ = (SEQ >> sh_) - 1, lb_ = (tr >> sh_) - 128 + 64 * (pp); \
        const int res_ = tr & ((1 << sh_) - 1); const bf16* Kp_ = K1 + hb; const bf16* Vp_ = V1 + hb;     \
        _Pragma("unroll") for (int i = 0; i < 8; ++i) { int l_ = lb_ + 8 * i + (lane >> 3); l_ = l_ < 0 ? 0 : (l_ > lmax_ ? lmax_ : l_); const int to_ = ((l_ << sh_) + res_) * HD + (lane & 7) * 8; \
            KF[i] = *(const v4u*)(Kp_ + to_); VV[i] = *(const v4u*)(Vp_ + to_); } } while (0)
#define AT_ADV(pt, pp, hs) do { if (hs) { ++pp; if (pp >= 3) { ++pt; if (pt < 3) pp = plo2; else hs = false; } } } while (0)
    int lpat = 1, lp = plo1, cpat = 1, cp = plo1; bool lhas = true;
    v4u k0[8], k1[8], w0[8], w1[8];
    {
        const int row0 = tid >> 3, ch = tid & 7;
        const bf16* kg1 = K1 + hb + ch * 8; const bf16* vg1 = V1 + hb + ch * 8;
        LAS unsigned char* const skw = lds + row0 * 128 + ((ch ^ (row0 & 7)) << 4);
        LAS unsigned char* const svw = lds + SH_V + row0 * VPITCH + ch * 16;
        v4u kreg[7], vreg[7];
#pragma unroll
        for (int i = 0; i < 7; ++i) { int tk = t0 - 128 + row0 + 64 * i; tk = tk < 0 ? 0 : (tk > SEQ - 1 ? SEQ - 1 : tk);
            if (i < 6 || row0 < SH_ROWS - 384) { kreg[i] = *(const v4u*)(kg1 + tk * HD); vreg[i] = *(const v4u*)(vg1 + tk * HD); } }
        __syncthreads();
#pragma unroll
        for (int i = 0; i < 7; ++i)
            if (i < 6 || row0 < SH_ROWS - 384) { *(LAS v4u*)(skw + i * 8192) = kreg[i]; *(LAS v4u*)(svw + i * 64 * VPITCH) = vreg[i]; }
        asm volatile("" ::: "memory");
        AT_LOAD(k0, w0, lpat, lp); AT_ADV(lpat, lp, lhas);
        AT_LOAD(k1, w1, lpat, lp); AT_ADV(lpat, lp, lhas);
        __syncthreads();
        const int R0 = 32 * wave + 8 * half;
#pragma unroll
        for (int s = 0; s < 2; ++s) { const int kt = qfirst - 128 + 64 * s;
            if (kt + 63 >= 0) core(IntC<2>{}, lds + (R0 + 64 * s) * 128, lds + SH_V + (R0 + 64 * s) * VPITCH, dqa + 128 - 64 * s, -kt); }
        core(IntC<1>{}, lds + (R0 + 128) * 128, lds + SH_V + (R0 + 128) * VPITCH, dqa, -qfirst);
        float lq = l_part; lq += __shfl_xor(lq, 16); lq += __shfl_xor(lq, 32);
        LAS float* So = (LAS float*)(lds + SH_ST); LAS float* Sm = (LAS float*)(lds + SH_ML); LAS float* Sl = Sm + 128;
        const int qla = 16 * wave + qi, qlb = 8 * qi + wave;
#pragma unroll
        for (int db = 0; db < 4; ++db) *(LAS f32x4*)(So + qla * ST_PITCH + 16 * db + 4 * kg) = o[db];
        if (kg == 0) { Sm[qla] = m_run; Sl[qla] = lq; }
#pragma unroll
        for (int s = 0; s < 2; ++s) qf[s] = *(const bf16x8*)(Qn + (rowbase + tr + 16 * qi) * DA + h * HD + 32 * s + 8 * kg);
        __syncthreads();
#pragma unroll
        for (int db = 0; db < 4; ++db) o[db] = *(const LAS f32x4*)(So + qlb * ST_PITCH + 16 * db + 4 * kg);
        m_run = Sm[qlb]; l_part = kg == 0 ? Sl[qlb] : 0.f;
        __syncthreads();
    }
    auto compute = [&](const v4u (&kk)[8], const v4u (&vv)[8], int pat, int p) __attribute__((always_inline)) {
        const int sh = AT_SH(pat);
#pragma unroll
        for (int i = 0; i < 8; ++i) *(LAS v4u*)(vw + 8 * i * VPITCH) = vv[i];
#pragma unroll
        for (int i = 0; i < 8; ++i) *(LAS v4u*)(kw + 8 * i * 128) = kk[i];
        asm volatile("s_waitcnt lgkmcnt(0)" ::: "memory");
        const int A = ((16 >> sh) * qi) + 128 - 64 * p, lbn = 128 - 64 * p - (tr >> sh);
        if (pat == 2 && p == 2) core(IntC<1>{}, kl, vl, A, lbn); else core(IntC<2>{}, kl, vl, A, lbn);
    };
#define AT_STEP(KC, WC) { compute(KC, WC, cpat, cp); bool chas = true; AT_ADV(cpat, cp, chas); if (!chas) break; AT_LOAD(KC, WC, lpat, lp); AT_ADV(lpat, lp, lhas); }
    for (;;) {
        AT_STEP(k0, w0)
        AT_STEP(k1, w1)
    }
#undef AT_STEP
#undef AT_ADV
#undef AT_LOAD
#undef AT_SH
    float l = l_part; l += __shfl_xor(l, 16); l += __shfl_xor(l, 32);
    const float inv = 1.0f / l;
    bf16* orow = MIX + (rowbase + tr + 16 * qi) * D + h * HD + 4 * kg;
#pragma unroll
    for (int db = 0; db < 4; ++db) { v2u w; w.x = pk2(o[db][0] * inv, o[db][1] * inv); w.y = pk2(o[db][2] * inv, o[db][3] * inv); *(v2u*)(orow + 16 * db) = w; }
}

#define XB_TMO      128
#define XB_XCNT(j)  (256  + 64 * (j))
#define XB_XSUB(j)  (1280 + 64 * (j))
#define XB_XGEN(j)  (2304 + 64 * (j))
#define XB_TOP      3328
#define XB_TOPGEN   3392
#define XCD_BAR_WORDS 3456
#define XB_SPIN_CAP (1u << 18)

__device__ __forceinline__ unsigned xb_ld(unsigned* p)              { return __hip_atomic_load(p, __ATOMIC_RELAXED, __HIP_MEMORY_SCOPE_AGENT); }
__device__ __forceinline__ unsigned xb_add(unsigned* p, unsigned v) { return __hip_atomic_fetch_add(p, v, __ATOMIC_RELAXED, __HIP_MEMORY_SCOPE_AGENT); }
__device__ __forceinline__ unsigned xb_xcc_id() { return (unsigned)__builtin_amdgcn_s_getreg((3 << 11) | 20) & 0xFu; }
#define XB_SPIN(cond, bar) do { unsigned _sp = 0; while (cond) { __builtin_amdgcn_s_sleep(1); \
    if ((++_sp & 255u) == 0u) { if (xb_ld(&(bar)[XB_TMO])) break; if (_sp > XB_SPIN_CAP) { atomicAdd(&(bar)[XB_TMO], 1u); break; } } } } while (0)

struct XcdBarrier {
    unsigned* bar; unsigned x;
    volatile LAS unsigned* st;
};

__device__ __forceinline__ XcdBarrier xcd_barrier_post(unsigned* bar, volatile LAS unsigned* st) {
    XcdBarrier b; b.bar = bar; b.x = xb_xcc_id(); b.st = st;
    if (threadIdx.x == 0) (void)xb_add(&bar[XB_XCNT(b.x)], 1u);
    return b;
}
__device__ __forceinline__ void xcd_barrier_complete(unsigned* bar, unsigned x, unsigned& nloc, unsigned& nx) {
    const unsigned G = gridDim.x * gridDim.y * gridDim.z;
    unsigned sum, cnt, mine, sp = 0u;
    for (;;) {
        sum = 0u; cnt = 0u; mine = 0u;
#pragma unroll
        for (unsigned j = 0; j < 16; ++j) { const unsigned c = xb_ld(&bar[XB_XCNT(j)]); sum += c; cnt += (c > 0u) ? 1u : 0u; mine = (j == x) ? c : mine; }
        if (sum == G) break;
        __builtin_amdgcn_s_sleep(1);
        if ((++sp & 255u) == 0u) { if (xb_ld(&bar[XB_TMO])) break; if (sp > XB_SPIN_CAP) { atomicAdd(&bar[XB_TMO], 1u); break; } }
    }
    nloc = mine > 0u ? mine : 1u; nx = cnt > 0u ? cnt : 1u;
}

__device__ __forceinline__ void xcd_barrier(const XcdBarrier& b) {
    asm volatile("s_waitcnt vmcnt(0)" ::: "memory");
    __syncthreads();
    if (threadIdx.x == 0) {
        unsigned* bar = b.bar;
        __builtin_amdgcn_s_waitcnt(0);
        unsigned nloc = b.st[0], nx = b.st[1];
        if (nloc == 0u) { xcd_barrier_complete(bar, b.x, nloc, nx); b.st[0] = nloc; b.st[1] = nx; }
        const unsigned old = xb_add(&bar[XB_XSUB(b.x)], 1u);
        const unsigned gen = old / nloc;
        if (old + 1u == (gen + 1u) * nloc) {
            __builtin_amdgcn_fence(__ATOMIC_RELEASE, "agent");
            asm volatile("s_waitcnt vmcnt(0)" ::: "memory");
            const unsigned og = xb_add(&bar[XB_TOP], 1u);
            const unsigned tg = og / nx;
            if (og + 1u == (tg + 1u) * nx) xb_add(&bar[XB_TOPGEN], 1u);
            else XB_SPIN(xb_ld(&bar[XB_TOPGEN]) == tg, bar);
            __builtin_amdgcn_fence(__ATOMIC_ACQUIRE, "agent");
            xb_add(&bar[XB_XGEN(b.x)], 1u);
            asm volatile("s_waitcnt vmcnt(0)" ::: "memory");
        } else {
            XB_SPIN(xb_ld(&bar[XB_XGEN(b.x)]) == gen, bar);
            __builtin_amdgcn_fence(__ATOMIC_ACQUIRE, "agent");
            asm volatile("s_waitcnt vmcnt(0)" ::: "memory");
        }
    }
    __syncthreads();
}

__global__ void __launch_bounds__(NWAVES * 64, 2) mega_fwd(Args args) {
    extern __shared__ __attribute__((aligned(16))) unsigned char lds_raw[];
    cg::grid_group grid = cg::this_grid();
    LAS unsigned char* lds = (LAS unsigned char*)lds_raw;
    const int tid = threadIdx.x, lane = tid & 63, wave = __builtin_amdgcn_readfirstlane(tid >> 6);
    const int G = gridDim.x, bx = blockIdx.x;
    unsigned char* ws = args.ws;
    const float* x = args.in[0];
    const float *ffn1_norm = args.in[1], *w1g = args.in[2], *w1u = args.in[3], *w1d = args.in[4], *mix_norm = args.in[5], *w_in = args.in[6], *q_norm = args.in[7], *k_norm = args.in[8];
    const float *conv_w = args.in[9], *conv_b = args.in[10], *ln_g = args.in[11], *ln_b = args.in[12], *w_out = args.in[13], *ffn2_norm = args.in[14], *w2g = args.in[15], *w2u = args.in[16], *w2d = args.in[17];
    float* out = args.out;
    volatile LAS unsigned* bst = (volatile LAS unsigned*)(lds + LDS_BYTES - 64);
    if (tid < 2) bst[tid] = 0u;
    __syncthreads();
    const XcdBarrier xbar = xcd_barrier_post((unsigned*)ws, bst);
    if (ws == nullptr) grid.sync();
    bf16 *Wgu1 = (bf16*)(ws + WS_WGU1), *Wd1 = (bf16*)(ws + WS_WD1), *Win = (bf16*)(ws + WS_WIN), *Wout = (bf16*)(ws + WS_WOUT), *Wgu2 = (bf16*)(ws + WS_WGU2), *Wd2 = (bf16*)(ws + WS_WD2);
    float *SL1 = (float*)(ws + WS_SL1), *SL2 = (float*)(ws + WS_SL2);
    bf16 *AB = (bf16*)(ws + WS_AB), *HMID = (bf16*)(ws + WS_HMID), *Qb = (bf16*)(ws + WS_Q), *Kb = (bf16*)(ws + WS_K), *Vb = (bf16*)(ws + WS_V), *Gb = (bf16*)(ws + WS_G), *MIX = (bf16*)(ws + WS_MIX);

    {
        LAS float* scr = (LAS float*)(lds + wave * 16384);
        const int gw = bx * NWAVES + wave, NGW = G * NWAVES;
        constexpr int I_GU = 16 * (5632 / 32), I_D = 44 * 32, I_IN = 16 * (DIN / 32), I_O = 16 * 32;
        constexpr int NITEMS = 2 * I_GU + 2 * I_D + I_IN + I_O;
        for (int it = gw; it < NITEMS; it += NGW) {
            int r = it;
            if (r < I_GU) { gu_item(w1g, w1u, nullptr, Wgu1, r, scr, lane); continue; } r -= I_GU;
            if (r < I_GU) { gu_item(w2g, w2u, ffn2_norm, Wgu2, r, scr, lane); continue; } r -= I_GU;
            if (r < I_D) { nat_item(w1d, FF, D, Wd1, r, scr, lane); continue; } r -= I_D;
            if (r < I_D) { nat_item(w2d, FF, D, Wd2, r, scr, lane); continue; } r -= I_D;
            if (r < I_IN) { win_item(w_in, mix_norm, Win, r, scr, lane); continue; } r -= I_IN;
            nat_item(w_out, D, D, Wout, r, scr, lane);
        }
        {
            const f32x4* gr = (const f32x4*)ffn1_norm + lane;
            int m = gw;
            for (; m + 3 * NGW < M; m += 4 * NGW) {
                f32x4 v[4][4]; float sq[4];
#pragma unroll
                for (int q = 0; q < 4; ++q) { const f32x4* xr = (const f32x4*)(x + (size_t)(m + q * NGW) * D) + lane;
#pragma unroll
                    for (int j = 0; j < 4; ++j) v[q][j] = __builtin_nontemporal_load(xr + 64 * j); }
#pragma unroll
                for (int q = 0; q < 4; ++q) { float t = 0.f;
#pragma unroll
                    for (int j = 0; j < 4; ++j) t += (v[q][j].x * v[q][j].x + v[q][j].y * v[q][j].y) + (v[q][j].z * v[q][j].z + v[q][j].w * v[q][j].w);
                    sq[q] = 1.0f / sqrtf(wave_sum(t) * (1.f / D) + EPS); }
#pragma unroll
                for (int q = 0; q < 4; ++q) { unsigned long long* o8 = (unsigned long long*)(AB + (size_t)(m + q * NGW) * D) + lane; const float rstd = sq[q];
#pragma unroll
                    for (int j = 0; j < 4; ++j) { const f32x4 g = gr[64 * j]; o8[64 * j] = (unsigned long long)pk2(v[q][j].x * rstd * g.x, v[q][j].y * rstd * g.y) | ((unsigned long long)pk2(v[q][j].z * rstd * g.z, v[q][j].w * rstd * g.w) << 32); } }
            }
            for (; m < M; m += NGW) rms_row_to_bf16(x + (size_t)m * D, ffn1_norm, AB + (size_t)m * D, lane);
        }
    }
    xcd_barrier(xbar);
    {
        pg8::Gemm g{AB, Wgu1, M, 2 * FF, D}; pg8::StaticOrder S; S.init(M, 2 * FF, G, bx);
        pg8::EpiSwiglu<false> E{HMID, nullptr};
        pg8::gemm_phase<pg8::EpiSwiglu<false>, pg8::StaticOrder, true, true>(lds, g, S, E);
    }
    xcd_barrier(xbar);
    {
        pg8::Gemm g{HMID, Wd1, M, D, FF}; pg8::StaticOrder S; S.init(M, D, G, bx); S.rev = 1;
        pg8::EpiRes<0> E{x, AB, nullptr, SL1, 0.5f};
        pg8::gemm_phase<pg8::EpiRes<0>, pg8::StaticOrder, true, true>(lds, g, S, E);
    }
    xcd_barrier(xbar);
    {
        pg8::Gemm g{AB, Win, M, DIN, D}; pg8::StaticOrder S; S.init(M, DIN, G, bx);
        pg8::EpiWin E{ws, SL1, q_norm, k_norm};
        pg8::gemm_phase<pg8::EpiWin, pg8::StaticOrder, true, true>(lds, g, S, E);
    }
    xcd_barrier(xbar);
    {
        int tid4 = threadIdx.x; asm volatile("" : "+v"(tid4)); const int lane4 = tid4 & 63;
        conv_phase(lds, Gb, conv_w, conv_b, ln_g, ln_b, MIX, bx, G, tid4);
        if (G == 256) {
            const int xq = bx & 7, w = bx >> 3;
            for (int j = 0; j < 8; ++j) { const int bh = xq + 8 * (2 * j + (w >> 4)), span = (((w & 15) >> 1) + j) & 7, half = w & 1;
                attn_unit(lds, Qb, Kb, Vb, MIX, bh >> 3, bh & 7, span * 256, half, wave, tid4); }
        } else
        for (int u = bx; u < 8 * 256; u += G) { const int span = u >> 8, rem = u & 255, bh = rem >> 1, half = rem & 1;
            attn_unit(lds, Qb, Kb, Vb, MIX, bh >> 3, bh & 7, span * 256, half, wave, tid4); }
    }
    xcd_barrier(xbar);
    {
        pg8::Gemm g{MIX, Wout, M, D, D}; pg8::StaticOrder S; S.init(M, D, G, bx);
        pg8::EpiRes<1> E{nullptr, AB, nullptr, SL2, 1.0f};
        pg8::gemm_phase<pg8::EpiRes<1>, pg8::StaticOrder, true, true>(lds, g, S, E);
    }
    xcd_barrier(xbar);
    {
        pg8::Gemm g{AB, Wgu2, M, 2 * FF, D}; pg8::StaticOrder S; S.init(M, 2 * FF, G, bx);
        pg8::EpiSwiglu<true> E{HMID, SL2};
        pg8::gemm_phase<pg8::EpiSwiglu<true>, pg8::StaticOrder, true, true>(lds, g, S, E);
    }
    xcd_barrier(xbar);
    {
        pg8::Gemm g{HMID, Wd2, M, D, FF}; pg8::StaticOrder S; S.init(M, D, G, bx); S.rev = 1;
        pg8::EpiRes<2> E{nullptr, AB, out, nullptr, 0.5f};
        pg8::gemm_phase<pg8::EpiRes<2>, pg8::StaticOrder, true, true>(lds, g, S, E);
    }
}

extern "C" void kernel_launch(void* const* d_in, const int* in_sizes, int n_in, void* d_out, int out_size, void* d_ws, size_t ws_size, hipStream_t stream) {
    static int grid_blocks = 0;
    if (grid_blocks == 0) {
        if (n_in != 18 || out_size != M * D || ws_size < WS_END) { fprintf(stderr, "kernel_launch: unexpected shapes (n_in %d out %d ws %zu)\n", n_in, out_size, ws_size); grid_blocks = -1; return; }
        int dev = 0, cus = 0, per_cu = 0;
        (void)hipGetDevice(&dev);
        (void)hipDeviceGetAttribute(&cus, hipDeviceAttributeMultiprocessorCount, dev);
        (void)hipFuncSetAttribute((const void*)mega_fwd, hipFuncAttributeMaxDynamicSharedMemorySize, LDS_BYTES);
        (void)hipOccupancyMaxActiveBlocksPerMultiprocessor(&per_cu, (const void*)mega_fwd, NWAVES * 64, LDS_BYTES);
        if (per_cu < 1) { fprintf(stderr, "kernel_launch: occupancy query reports %d blocks per CU\n", per_cu); per_cu = 1; }
        grid_blocks = cus * 1;
    }
    if (grid_blocks < 0) return;
    if (hipMemsetAsync(d_ws, 0, XCD_BAR_WORDS * sizeof(unsigned), stream) != hipSuccess) { fprintf(stderr, "kernel_launch: hipMemsetAsync of the barrier words failed\n"); return; }
    Args a{};
    for (int i = 0; i < 18; ++i) a.in[i] = (const float*)d_in[i];
    a.out = (float*)d_out; a.ws = (unsigned char*)d_ws;
    void* kargs[] = {&a};
    hipError_t e = hipLaunchCooperativeKernel((const void*)mega_fwd, dim3(grid_blocks), dim3(NWAVES * 64), kargs, LDS_BYTES, stream);
    if (e != hipSuccess) fprintf(stderr, "cooperative launch failed: %s (grid %d)\n", hipGetErrorString(e), grid_blocks);
}
```
